# Optimizing an MI355X kernel written in HIP

```python
import math
import jax, jax.numpy as jnp
from jax import lax
import numpy as np

D_MODEL = 2048
BATCH = 2
SEQ = 4096
DEPTH = 2

HEAD_DIM = 64
N_Q_HEADS = 16
N_KV_HEADS = 4
GQA_GROUP = N_Q_HEADS // N_KV_HEADS
ATTN_WIDTH = N_Q_HEADS * HEAD_DIM
KV_WIDTH = N_KV_HEADS * HEAD_DIM
WINDOW = 128
BLOCK = 128
SSM_WIDTH = D_MODEL // 2
SSM_GROUP_CH = 16
SSM_GROUPS = SSM_WIDTH // SSM_GROUP_CH
SSM_STATE = 64
DT_MIN = 1e-3
DT_MAX = 1e-1
D_FF = -(-8 * D_MODEL // (3 * 256)) * 256
OFF_Q = 0
OFF_K = OFF_Q + ATTN_WIDTH
OFF_V = OFF_K + KV_WIDTH
OFF_U = OFF_V + KV_WIDTH
OFF_G = OFF_U + SSM_WIDTH
IN_WIDTH = OFF_G + 2 * D_MODEL
RMS_EPS = 1e-6

kernel_name = "hybrid_swa_sink_s5_gated_block"


def rmsnorm(x, g):
    xf = x.astype(jnp.float32)
    y = xf * lax.rsqrt(jnp.mean(xf * xf, axis=-1, keepdims=True) + RMS_EPS)
    return (y * g.astype(jnp.float32)).astype(x.dtype)


def alibi_slopes():
    return jnp.exp2(-8.0 * jnp.arange(1, N_Q_HEADS + 1, dtype=jnp.float32) / N_Q_HEADS)


def sliding_window_attention(q, k, v, q_gain, k_gain, sinks):
    B, L = q.shape[0], q.shape[1]
    nb = L // BLOCK
    q = rmsnorm(q, q_gain).astype(jnp.float32)
    k = rmsnorm(k, k_gain).astype(jnp.float32)
    v = v.astype(jnp.float32)
    qb = q.reshape(B, nb, BLOCK, N_KV_HEADS, GQA_GROUP, HEAD_DIM)
    pad = ((0, 0), (BLOCK, 0), (0, 0), (0, 0))
    kp = jnp.pad(k, pad)[:, :L].reshape(B, nb, BLOCK, N_KV_HEADS, HEAD_DIM)
    vp = jnp.pad(v, pad)[:, :L].reshape(B, nb, BLOCK, N_KV_HEADS, HEAD_DIM)
    kb = jnp.concatenate([kp, k.reshape(B, nb, BLOCK, N_KV_HEADS, HEAD_DIM)], axis=2)
    vb = jnp.concatenate([vp, v.reshape(B, nb, BLOCK, N_KV_HEADS, HEAD_DIM)], axis=2)
    scores = jnp.einsum('bnqkgd,bnskd->bnkgqs', qb, kb) * (HEAD_DIM ** -0.5)
    t_loc = jnp.arange(BLOCK)
    s_loc = jnp.arange(2 * BLOCK) - BLOCK
    dist = (t_loc[:, None] - s_loc[None, :]).astype(jnp.float32)
    s_abs = jnp.arange(nb)[:, None] * BLOCK + s_loc[None, :]
    valid = (dist >= 0)[None] & (dist < WINDOW)[None] & (s_abs >= 0)[:, None, :]
    bias = (-alibi_slopes()[:, None, None] * dist[None]).reshape(N_KV_HEADS, GQA_GROUP, BLOCK, 2 * BLOCK)
    scores = jnp.where(valid[None, :, None, None], scores + bias[None, None], -jnp.inf)
    sink = sinks.astype(jnp.float32).reshape(1, 1, N_KV_HEADS, GQA_GROUP, 1, 1)
    m = jnp.maximum(jnp.max(scores, axis=-1, keepdims=True), sink)
    p = jnp.exp(scores - m)
    denom = jnp.sum(p, axis=-1, keepdims=True) + jnp.exp(sink - m)
    out = jnp.einsum('bnkgqs,bnskd->bnqkgd', p / denom, vb)
    return out.reshape(B, L, ATTN_WIDTH)


def s5_ssm(u, lam_re, lam_im, log_dt, b_re, b_im, c_re, c_im, d_skip):
    B, L = u.shape[0], u.shape[1]
    uf = u.astype(jnp.float32).reshape(B, L, SSM_GROUPS, SSM_GROUP_CH)
    lr = lam_re.astype(jnp.float32)
    li = lam_im.astype(jnp.float32)
    dt = jnp.exp(log_dt.astype(jnp.float32))[:, None]
    mag = jnp.exp(lr * dt)
    ar = mag * jnp.cos(li * dt)
    ai = mag * jnp.sin(li * dt)
    den = lr * lr + li * li
    fr = ((ar - 1.0) * lr + ai * li) / den
    fi = (ai * lr - (ar - 1.0) * li) / den
    br = b_re.astype(jnp.float32)
    bi = b_im.astype(jnp.float32)
    bbar_r = fr[:, :, None] * br - fi[:, :, None] * bi
    bbar_i = fr[:, :, None] * bi + fi[:, :, None] * br
    bu_r = jnp.einsum('blgh,gph->blgp', uf, bbar_r)
    bu_i = jnp.einsum('blgh,gph->blgp', uf, bbar_i)
    a_r = jnp.broadcast_to(ar[None, None], (1, L, SSM_GROUPS, SSM_STATE))
    a_i = jnp.broadcast_to(ai[None, None], (1, L, SSM_GROUPS, SSM_STATE))

    def combine(e1, e2):
        ar1, ai1, br1, bi1 = e1
        ar2, ai2, br2, bi2 = e2
        return (ar2 * ar1 - ai2 * ai1,
                ar2 * ai1 + ai2 * ar1,
                ar2 * br1 - ai2 * bi1 + br2,
                ar2 * bi1 + ai2 * br1 + bi2)

    _, _, s_r, s_i = lax.associative_scan(combine, (a_r, a_i, bu_r, bu_i), axis=1)
    y = (jnp.einsum('blgp,ghp->blgh', s_r, c_re.astype(jnp.float32))
         - jnp.einsum('blgp,ghp->blgh', s_i, c_im.astype(jnp.float32))
         + d_skip.astype(jnp.float32).reshape(SSM_GROUPS, SSM_GROUP_CH) * uf)
    return y.reshape(B, L, SSM_WIDTH)


def setup_inputs(seed: int = 0) -> dict:
    key = jax.random.key(seed)
    ks = jax.random.split(key, 24)
    f32 = jnp.float32
    nrm = lambda k, shape, scale: jax.random.normal(k, shape, f32) * scale
    x = jax.random.normal(ks[0], (BATCH, SEQ, D_MODEL), f32)
    norm_mix_g = 1.0 + nrm(ks[1], (DEPTH, D_MODEL), 0.02)
    w_in = nrm(ks[2], (DEPTH, D_MODEL, IN_WIDTH), D_MODEL ** -0.5)
    gate_bias = nrm(ks[3], (DEPTH, 2 * D_MODEL), 0.02)
    q_norm_g = 1.0 + nrm(ks[4], (DEPTH, HEAD_DIM), 0.02)
    k_norm_g = 1.0 + nrm(ks[5], (DEPTH, HEAD_DIM), 0.02)
    attn_sinks = nrm(ks[6], (DEPTH, N_Q_HEADS), 0.5)
    ssm_lambda_re = -0.5 + nrm(ks[7], (DEPTH, SSM_GROUPS, SSM_STATE), 0.01)
    ssm_lambda_im = (math.pi * jnp.arange(SSM_STATE, dtype=f32))[None, None, :] + nrm(ks[8], (DEPTH, SSM_GROUPS, SSM_STATE), 0.01)
    ssm_log_dt = jax.random.uniform(ks[9], (DEPTH, SSM_GROUPS), f32, math.log(DT_MIN), math.log(DT_MAX))
    ssm_b_re = nrm(ks[10], (DEPTH, SSM_GROUPS, SSM_STATE, SSM_GROUP_CH), (2 * SSM_GROUP_CH) ** -0.5)
    ssm_b_im = nrm(ks[11], (DEPTH, SSM_GROUPS, SSM_STATE, SSM_GROUP_CH), (2 * SSM_GROUP_CH) ** -0.5)
    ssm_c_re = nrm(ks[12], (DEPTH, SSM_GROUPS, SSM_GROUP_CH, SSM_STATE), (2 * SSM_STATE) ** -0.5)
    ssm_c_im = nrm(ks[13], (DEPTH, SSM_GROUPS, SSM_GROUP_CH, SSM_STATE), (2 * SSM_STATE) ** -0.5)
    ssm_d = nrm(ks[14], (DEPTH, SSM_WIDTH), 1.0)
    ssm_glu_w = nrm(ks[15], (DEPTH, SSM_WIDTH, SSM_WIDTH), SSM_WIDTH ** -0.5)
    ssm_glu_b = nrm(ks[16], (DEPTH, SSM_WIDTH), 0.02)
    w_attn_branch = nrm(ks[17], (DEPTH, ATTN_WIDTH, D_MODEL), ATTN_WIDTH ** -0.5)
    w_ssm_branch = nrm(ks[18], (DEPTH, SSM_WIDTH, D_MODEL), SSM_WIDTH ** -0.5)
    w_out = nrm(ks[19], (DEPTH, D_MODEL, D_MODEL), D_MODEL ** -0.5)
    norm_ffn_g = 1.0 + nrm(ks[20], (DEPTH, D_MODEL), 0.02)
    w_ffn_in = nrm(ks[21], (DEPTH, D_MODEL, 2 * D_FF), D_MODEL ** -0.5)
    w_ffn_out = nrm(ks[22], (DEPTH, D_FF, D_MODEL), D_FF ** -0.5)
    return {"x": x, "norm_mix_g": norm_mix_g, "w_in": w_in, "gate_bias": gate_bias,
            "q_norm_g": q_norm_g, "k_norm_g": k_norm_g, "attn_sinks": attn_sinks,
            "ssm_lambda_re": ssm_lambda_re, "ssm_lambda_im": ssm_lambda_im, "ssm_log_dt": ssm_log_dt,
            "ssm_b_re": ssm_b_re, "ssm_b_im": ssm_b_im, "ssm_c_re": ssm_c_re, "ssm_c_im": ssm_c_im,
            "ssm_d": ssm_d, "ssm_glu_w": ssm_glu_w, "ssm_glu_b": ssm_glu_b,
            "w_attn_branch": w_attn_branch, "w_ssm_branch": w_ssm_branch, "w_out": w_out,
            "norm_ffn_g": norm_ffn_g, "w_ffn_in": w_ffn_in, "w_ffn_out": w_ffn_out}


def reference(x, norm_mix_g, w_in, gate_bias, q_norm_g, k_norm_g, attn_sinks,
              ssm_lambda_re, ssm_lambda_im, ssm_log_dt, ssm_b_re, ssm_b_im, ssm_c_re, ssm_c_im,
              ssm_d, ssm_glu_w, ssm_glu_b, w_attn_branch, w_ssm_branch, w_out,
              norm_ffn_g, w_ffn_in, w_ffn_out):
    B, L = x.shape[0], x.shape[1]
    for l in range(DEPTH):
        h = rmsnorm(x, norm_mix_g[l])
        z = h @ w_in[l]
        q = z[..., OFF_Q:OFF_K].reshape(B, L, N_Q_HEADS, HEAD_DIM)
        k = z[..., OFF_K:OFF_V].reshape(B, L, N_KV_HEADS, HEAD_DIM)
        v = z[..., OFF_V:OFF_U].reshape(B, L, N_KV_HEADS, HEAD_DIM)
        u = z[..., OFF_U:OFF_G]
        gates = jax.nn.sigmoid(z[..., OFF_G:] + gate_bias[l])
        g_attn = gates[..., :D_MODEL]
        g_ssm = gates[..., D_MODEL:]
        y_attn = sliding_window_attention(q, k, v, q_norm_g[l], k_norm_g[l], attn_sinks[l]).astype(x.dtype)
        y_ssm = s5_ssm(u, ssm_lambda_re[l], ssm_lambda_im[l], ssm_log_dt[l], ssm_b_re[l], ssm_b_im[l],
                       ssm_c_re[l], ssm_c_im[l], ssm_d[l])
        y_ssm = jax.nn.gelu(y_ssm)
        y_ssm = (y_ssm * jax.nn.sigmoid(y_ssm @ ssm_glu_w[l].astype(jnp.float32)
                                        + ssm_glu_b[l].astype(jnp.float32))).astype(x.dtype)
        merged = g_attn * (y_attn @ w_attn_branch[l]) + g_ssm * (y_ssm @ w_ssm_branch[l])
        x = x + merged @ w_out[l]
        h2 = rmsnorm(x, norm_ffn_g[l])
        gu = h2 @ w_ffn_in[l]
        x = x + (jax.nn.silu(gu[..., :D_FF]) * gu[..., D_FF:]) @ w_ffn_out[l]
    return x
```

```cpp
#include <hip/hip_runtime.h>
#include <hip/hip_cooperative_groups.h>
#include <cstdio>
#include <cstdint>
#include <cmath>
namespace cg = cooperative_groups;
namespace pg8 {
#define PG8_LAS __attribute__((address_space(3)))
typedef unsigned short bf16_t;
typedef short bf16x8 __attribute__((ext_vector_type(8)));
typedef float f32x4 __attribute__((ext_vector_type(4)));
typedef unsigned u32x4 __attribute__((ext_vector_type(4)));
constexpr int BM = 256, BK = 64, HALF = 128, HTB = HALF * BK * 2  , STAGE_BYTES = 8 * HTB, NXCD = 8, WGM = 8;

__host__ __device__ __forceinline__ int lds_byte(int r, int c) { const int st = (r >> 4) * 2 + (c >> 5), rr = r & 15, cc = c & 31, ob = rr * 64 + cc * 2; return st * 1024 + (ob ^ (((ob >> 9) & 1) << 5)); }
__host__ __device__ __forceinline__ void stage_rc(int b, int& R, int& C) { const int st = b / 1024, sb = b % 1024, swz = sb ^ (((sb >> 9) & 1) << 5); R = (st >> 1) * 16 + swz / 64; C = (st & 1) * 32 + (swz % 64) / 2; }
__host__ __device__ __forceinline__ int perm32(int rho) { const int n = rho >> 4, i = rho & 15; return 8 * (i >> 2) + 4 * n + (i & 3); }

struct Unit { int pm, pn; };
struct Gemm { const bf16_t* A; const bf16_t* Bt; int M, N, K; };

struct StaticOrder {
    int nM, nN, nwg, G, c;
    __host__ __device__ void init(int M, int N, int G_, int c_) { nM = M / BM; nN = N / BM; nwg = nM * nN; G = G_; c = c_; }
    __host__ __device__ bool next(int i, Unit& u) const {
        const long L = (long)i * G + c; if (L >= nwg) return false;
        int wgid = (int)L; { const int q = nwg / NXCD, r = nwg % NXCD, xcd = wgid % NXCD, off = wgid / NXCD; wgid = (xcd < r ? xcd * (q + 1) : r * (q + 1) + (xcd - r) * q) + off; }
        const int nig = WGM * nN, gid = wgid / nig, fm = gid * WGM, gsz = (nM - fm) < WGM ? (nM - fm) : WGM;
        u.pm = fm + ((wgid % nig) % gsz); u.pn = (wgid % nig) / gsz; return true;
    }
    __device__ __forceinline__ void a_ready(const Unit&) const {}
    __device__ __forceinline__ void done(const Unit&) const {}
};

__device__ __forceinline__ unsigned cvt_pk_bf16(float lo, float hi) { unsigned r; asm volatile("v_cvt_pk_bf16_f32 %0, %1, %2" : "=v"(r) : "v"(lo), "v"(hi)); return r; }
typedef float f32x2 __attribute__((ext_vector_type(2)));
__device__ __forceinline__ f32x2 gelu_pk(f32x2 v) {
    const f32x2 av = __builtin_elementwise_abs(v), d = av * 0.2316418882f + 1.0f;
    f32x2 t; t.x = __builtin_amdgcn_rcpf(d.x); t.y = __builtin_amdgcn_rcpf(d.y);
    f32x2 q = t * 0.5307027145f + (-0.7265760135f); q = q * t + 0.7107068705f; q = q * t + (-0.142248368f); q = q * t + 0.127414796f; q = q * t;
    const f32x2 s = (v * v) * (-0.72134752044f);
    f32x2 e; e.x = __builtin_amdgcn_exp2f(s.x); e.y = __builtin_amdgcn_exp2f(s.y);
    const f32x2 m = v * (q * e), r = v - m;
    f32x2 o; o.x = v.x < 0.f ? m.x : r.x; o.y = v.y < 0.f ? m.y : r.y; return o;
}

constexpr float RMS_EPS_F = 1e-6f;
__device__ __forceinline__ float sigm(float v) { return __builtin_amdgcn_rcpf(1.0f + __builtin_amdgcn_exp2f(-1.4426950408889634f * v)); }
__device__ __forceinline__ float bf_lo(unsigned w) { return __uint_as_float(w << 16); }
__device__ __forceinline__ float bf_hi(unsigned w) { return __uint_as_float(w & 0xffff0000u); }
__device__ __forceinline__ void unpack8(const u32x4 w, float (&f)[8]) { f[0] = bf_lo(w.x); f[1] = bf_hi(w.x); f[2] = bf_lo(w.y); f[3] = bf_hi(w.y); f[4] = bf_lo(w.z); f[5] = bf_hi(w.z); f[6] = bf_lo(w.w); f[7] = bf_hi(w.w); }
__device__ __forceinline__ u32x4 pack8(const float (&f)[8]) { u32x4 w; w.x = cvt_pk_bf16(f[0], f[1]); w.y = cvt_pk_bf16(f[2], f[3]); w.z = cvt_pk_bf16(f[4], f[5]); w.w = cvt_pk_bf16(f[6], f[7]); return w; }
#define EPI_LOOP_ROWS for (int ai = 0; ai < 2; ++ai) _Pragma("unroll") for (int m = 0; m < 4; ++m)

struct EpiWin {
    static constexpr bool PERM = true, AFTER_DRAIN = false;
    bf16_t* Z; int ldz; const float* ssq; const float* gbias; int gate_pn0; float inv_d;
    __device__ __forceinline__ void operator()(const f32x4 (&acc)[2][2][4][2], const Unit& u, int wr, int wc, int fr, int fq) const {
        const int row0 = u.pm * BM + wr * 64 + fr, col0 = u.pn * BM + wc * 32 + 8 * fq;
        const bool gate = u.pn >= gate_pn0;
        f32x4 bv[2][2];
#pragma unroll
        for (int bj = 0; bj < 2; ++bj)
#pragma unroll
            for (int n = 0; n < 2; ++n) bv[bj][n] = gate ? *(const f32x4*)(gbias + (col0 - gate_pn0 * BM) + bj * HALF + 4 * n) : (f32x4){0.f, 0.f, 0.f, 0.f};
#pragma unroll
        EPI_LOOP_ROWS { const int row = row0 + ai * HALF + m * 16; const float rs = rsqrtf(ssq[row] * inv_d + RMS_EPS_F); bf16_t* rowp = Z + (size_t)row * ldz + col0;
#pragma unroll
            for (int bj = 0; bj < 2; ++bj) { f32x4 v0 = acc[ai][bj][m][0] * rs, v1 = acc[ai][bj][m][1] * rs;
                if (gate) { v0 += bv[bj][0]; v1 += bv[bj][1];
#pragma unroll
                    for (int j = 0; j < 4; ++j) { v0[j] = sigm(v0[j]); v1[j] = sigm(v1[j]); } }
                u32x4 w; w.x = cvt_pk_bf16(v0[0], v0[1]); w.y = cvt_pk_bf16(v0[2], v0[3]); w.z = cvt_pk_bf16(v1[0], v1[1]); w.w = cvt_pk_bf16(v1[2], v1[3]);
                *(u32x4*)(rowp + bj * HALF) = w; } }
    }
};
struct EpiGlu {
    static constexpr bool PERM = true, AFTER_DRAIN = false;
    bf16_t* O; const bf16_t* YG; int ld; const float* bias;
    __device__ __forceinline__ void operator()(const f32x4 (&acc)[2][2][4][2], const Unit& u, int wr, int wc, int fr, int fq) const {
        const int row0 = u.pm * BM + wr * 64 + fr, col0 = u.pn * BM + wc * 32 + 8 * fq;
        f32x4 bv[2][2];
#pragma unroll
        for (int bj = 0; bj < 2; ++bj)
#pragma unroll
            for (int n = 0; n < 2; ++n) bv[bj][n] = *(const f32x4*)(bias + col0 + bj * HALF + 4 * n);
#pragma unroll
        EPI_LOOP_ROWS { const size_t off = (size_t)(row0 + ai * HALF + m * 16) * ld + col0;
#pragma unroll
            for (int bj = 0; bj < 2; ++bj) { const f32x4 v0 = acc[ai][bj][m][0] + bv[bj][0], v1 = acc[ai][bj][m][1] + bv[bj][1];
                float y[8]; unpack8(*(const u32x4*)(YG + off + bj * HALF), y); float o[8];
#pragma unroll
                for (int j = 0; j < 4; ++j) { o[j] = y[j] * sigm(v0[j]); o[4 + j] = y[4 + j] * sigm(v1[j]); }
                *(u32x4*)(O + off + bj * HALF) = pack8(o); } }
    }
};
template <bool FIRST> struct EpiGateMerge {
    static constexpr bool PERM = true, AFTER_DRAIN = false;
    float* T; bf16_t* O; int ld; const bf16_t* G; int ldg;
    __device__ __forceinline__ void operator()(const f32x4 (&acc)[2][2][4][2], const Unit& u, int wr, int wc, int fr, int fq) const {
        const int row0 = u.pm * BM + wr * 64 + fr, col0 = u.pn * BM + wc * 32 + 8 * fq;
#pragma unroll
        EPI_LOOP_ROWS { const int row = row0 + ai * HALF + m * 16; const size_t off = (size_t)row * ld + col0; const size_t goff = (size_t)row * ldg + col0;
#pragma unroll
            for (int bj = 0; bj < 2; ++bj) { float g[8]; unpack8(*(const u32x4*)(G + goff + bj * HALF), g);
                f32x4 v0 = acc[ai][bj][m][0], v1 = acc[ai][bj][m][1];
#pragma unroll
                for (int j = 0; j < 4; ++j) { v0[j] *= g[j]; v1[j] *= g[4 + j]; }
                if (FIRST) { *(f32x4*)(T + off + bj * HALF) = v0; *(f32x4*)(T + off + bj * HALF + 4) = v1; }
                else { v0 += *(const f32x4*)(T + off + bj * HALF); v1 += *(const f32x4*)(T + off + bj * HALF + 4);
                    u32x4 w; w.x = cvt_pk_bf16(v0[0], v0[1]); w.y = cvt_pk_bf16(v0[2], v0[3]); w.z = cvt_pk_bf16(v1[0], v1[1]); w.w = cvt_pk_bf16(v1[2], v1[3]);
                    *(u32x4*)(O + off + bj * HALF) = w; } } }
    }
};
struct EpiResid {
    static constexpr bool PERM = true, AFTER_DRAIN = false;
    const float* res; float* out; bf16_t* outb; int ld; float* ssq_out;
    __device__ __forceinline__ void operator()(const f32x4 (&acc)[2][2][4][2], const Unit& u, int wr, int wc, int fr, int fq) const {
        const int row0 = u.pm * BM + wr * 64 + fr, col0 = u.pn * BM + wc * 32 + 8 * fq;
#pragma unroll
        EPI_LOOP_ROWS { const int row = row0 + ai * HALF + m * 16; const size_t off = (size_t)row * ld + col0; float s = 0.f;
#pragma unroll
            for (int bj = 0; bj < 2; ++bj) {
                const f32x4 v0 = acc[ai][bj][m][0] + *(const f32x4*)(res + off + bj * HALF), v1 = acc[ai][bj][m][1] + *(const f32x4*)(res + off + bj * HALF + 4);
                *(f32x4*)(out + off + bj * HALF) = v0; *(f32x4*)(out + off + bj * HALF + 4) = v1;
                u32x4 w; w.x = cvt_pk_bf16(v0[0], v0[1]); w.y = cvt_pk_bf16(v0[2], v0[3]); w.z = cvt_pk_bf16(v1[0], v1[1]); w.w = cvt_pk_bf16(v1[2], v1[3]);
                *(u32x4*)(outb + off + bj * HALF) = w;
                s += (v0[0] * v0[0] + v0[1] * v0[1]) + (v0[2] * v0[2] + v0[3] * v0[3]) + (v1[0] * v1[0] + v1[1] * v1[1]) + (v1[2] * v1[2] + v1[3] * v1[3]); }
            if (ssq_out) { s += __shfl_xor(s, 16); s += __shfl_xor(s, 32); if (fq == 0) __hip_atomic_fetch_add(ssq_out + row, s, __ATOMIC_RELAXED, __HIP_MEMORY_SCOPE_AGENT); } }
    }
};
struct EpiSwiglu {
    static constexpr bool PERM = true, AFTER_DRAIN = false;
    bf16_t* O; int ldo; const float* ssq; float inv_d;
    __device__ __forceinline__ void operator()(const f32x4 (&acc)[2][2][4][2], const Unit& u, int wr, int wc, int fr, int fq) const {
        const int row0 = u.pm * BM + wr * 64 + fr, col0 = u.pn * HALF + wc * 32 + 8 * fq;
#pragma unroll
        EPI_LOOP_ROWS { const int row = row0 + ai * HALF + m * 16; const float rs = rsqrtf(ssq[row] * inv_d + RMS_EPS_F);
            float o[8];
#pragma unroll
            for (int n = 0; n < 2; ++n)
#pragma unroll
                for (int j = 0; j < 4; ++j) { const float g = acc[ai][0][m][n][j] * rs, up = acc[ai][1][m][n][j] * rs; o[4 * n + j] = g * sigm(g) * up; }
            *(u32x4*)(O + (size_t)row * ldo + col0) = pack8(o); }
    }
};
template <class Epi, class Sched, bool ALIGN_EPI = false, bool SP2 = false>
__device__ __forceinline__ void gemm_phase(PG8_LAS unsigned char* lds, const Gemm g, const Sched& S, const Epi& E) {
    int tid_ = threadIdx.x; asm volatile("" : "+v"(tid_));
    const int tid = tid_, wid = __builtin_amdgcn_readfirstlane(tid >> 6), lane = tid & 63, wr = wid >> 2, wc = wid & 3, fr = lane & 15, fq = lane >> 4;
    const int K = g.K, nt = K / BK;
    unsigned voffA[2], voffB[2];
#pragma unroll
    for (int i = 0; i < 2; ++i) { int R, C; stage_rc(tid * 16 + i * 8192, R, C); const int Rb = Epi::PERM ? ((R & ~31) + perm32(R & 31)) : R;
        voffA[i] = (unsigned)(R * K + C) * 2u; voffB[i] = (unsigned)(Rb * K + C) * 2u; }
    const size_t kstep = (size_t)(BK * 2);
    const size_t hstep = (size_t)HALF * K * 2;
    const size_t tstep = 2 * hstep;
    const unsigned ldsw = (unsigned)wid * 1024u;
    const int aoff = lds_byte(wr * 64 + fr, fq * 8), boff = lds_byte(wc * 32 + fr, fq * 8);
#define PG8_SA(b, h) (((b) * 2 + (h)) * HTB)
#define PG8_SB(b, h) ((4 + (b) * 2 + (h)) * HTB)
#define PG8_STAGE(bufoff, gbase, voff) do { _Pragma("unroll") for (int _i = 0; _i < 2; ++_i) \
        __builtin_amdgcn_global_load_lds((const unsigned*)((const char*)(gbase) + (voff)[_i]), (PG8_LAS unsigned*)(lds + (bufoff) + ldsw + _i * 8192), 16, 0, 0); } while (0)
#define PG8_LDA(dst, b, h) do { _Pragma("unroll") for (int m = 0; m < 4; ++m) _Pragma("unroll") for (int k = 0; k < 2; ++k) dst[m][k] = *(const PG8_LAS bf16x8*)(lds + PG8_SA(b, h) + aoff + m * 2048 + k * 1024); } while (0)
#define PG8_LDB(dst, b, h) do { _Pragma("unroll") for (int n = 0; n < 2; ++n) _Pragma("unroll") for (int k = 0; k < 2; ++k) dst[n][k] = *(const PG8_LAS bf16x8*)(lds + PG8_SB(b, h) + boff + n * 2048 + k * 1024); } while (0)
#define PG8_MMA(ai, bj, At, Bt) do { __builtin_amdgcn_s_setprio(1); _Pragma("unroll") for (int m = 0; m < 4; ++m) _Pragma("unroll") for (int n = 0; n < 2; ++n) _Pragma("unroll") for (int k = 0; k < 2; ++k) \
        acc[ai][bj][m][n] = __builtin_amdgcn_mfma_f32_16x16x32_bf16(Bt[n][k], At[m][k], acc[ai][bj][m][n], 0, 0, 0); __builtin_amdgcn_s_setprio(0); } while (0)
#define PG8_WAIT_V(n) asm volatile("s_waitcnt vmcnt(" #n ")" ::: "memory")
#define PG8_WAIT_L(n) asm volatile("s_waitcnt lgkmcnt(" #n ")" ::: "memory")
#define PG8_BAR __builtin_amdgcn_s_barrier()
#define PG8_SCHED __builtin_amdgcn_sched_barrier(0)
    Unit cur, nxt; int ui = 0;
    if (!S.next(0, cur)) return;
    f32x4 acc[2][2][4][2];
#pragma unroll
    for (int a = 0; a < 2; ++a)
#pragma unroll
        for (int b = 0; b < 2; ++b)
#pragma unroll
            for (int m = 0; m < 4; ++m)
#pragma unroll
                for (int n = 0; n < 2; ++n) acc[a][b][m][n] = (f32x4){0.f, 0.f, 0.f, 0.f};
    bf16x8 At[4][2], B0[2][2], B1[2][2];
    const char* cA = (const char*)g.A + (size_t)cur.pm * tstep; const char* cB = (const char*)g.Bt + (size_t)cur.pn * tstep;
    S.a_ready(cur);
    if constexpr (SP2) {
        PG8_STAGE(PG8_SB(0, 0), cB, voffB); PG8_STAGE(PG8_SB(0, 1), cB + hstep, voffB); PG8_STAGE(PG8_SA(0, 0), cA, voffA); PG8_STAGE(PG8_SA(0, 1), cA + hstep, voffA);
        if (wr == 1) PG8_BAR;
        PG8_WAIT_V(2); PG8_BAR;
        PG8_STAGE(PG8_SB(1, 0), cB + kstep, voffB); PG8_STAGE(PG8_SA(1, 0), cA + kstep, voffA); PG8_STAGE(PG8_SB(1, 1), cB + hstep + kstep, voffB);
        PG8_WAIT_V(6); PG8_BAR;
    } else {
        PG8_STAGE(PG8_SB(0, 0), cB, voffB); PG8_STAGE(PG8_SA(0, 0), cA, voffA); PG8_STAGE(PG8_SB(0, 1), cB + hstep, voffB); PG8_STAGE(PG8_SA(0, 1), cA + hstep, voffA);
        if (wr == 1) PG8_BAR;
        PG8_WAIT_V(4); PG8_BAR;
        PG8_STAGE(PG8_SB(1, 0), cB + kstep, voffB); PG8_STAGE(PG8_SA(1, 0), cA + kstep, voffA); PG8_STAGE(PG8_SB(1, 1), cB + hstep + kstep, voffB);
        PG8_WAIT_V(6); PG8_BAR;
    }
    for (;;) {
        const bool has_next = S.next(ui + 1, nxt);
        const char* nA = has_next ? (const char*)g.A + (size_t)nxt.pm * tstep : cA; const char* nB = has_next ? (const char*)g.Bt + (size_t)nxt.pn * tstep : cB;
        for (int t = 0; t < nt; t += 2) {
            const bool last = (t == nt - 2);
            const char* a1 = cA + (size_t)(t + 1) * kstep;
            const char* a2 = last ? nA : cA + (size_t)(t + 2) * kstep; const char* b2 = last ? nB : cB + (size_t)(t + 2) * kstep;
            const char* a3 = a2 + kstep; const char* b3 = b2 + kstep;
            if (last && has_next) S.a_ready(nxt);
            if constexpr (SP2) {
            PG8_LDB(B0, 0, 0); PG8_LDB(B1, 0, 1); PG8_SCHED; PG8_LDA(At, 0, 0); PG8_STAGE(PG8_SA(1, 1), a1 + hstep, voffA);
            PG8_WAIT_V(8); PG8_WAIT_L(0); PG8_BAR; PG8_MMA(0, 0, At, B0); PG8_MMA(0, 1, At, B1); PG8_BAR; PG8_SCHED;
            PG8_LDA(At, 0, 1); PG8_STAGE(PG8_SB(0, 0), b2, voffB); PG8_STAGE(PG8_SB(0, 1), b2 + hstep, voffB); PG8_STAGE(PG8_SA(0, 0), a2, voffA);
            PG8_WAIT_V(8); PG8_WAIT_L(0); PG8_BAR; PG8_MMA(1, 0, At, B0); PG8_MMA(1, 1, At, B1); PG8_BAR; PG8_SCHED;
            PG8_LDB(B0, 1, 0); PG8_LDB(B1, 1, 1); PG8_SCHED; PG8_LDA(At, 1, 0); PG8_STAGE(PG8_SA(0, 1), a2 + hstep, voffA);
            PG8_WAIT_V(8); PG8_WAIT_L(0); PG8_BAR; PG8_MMA(0, 0, At, B0); PG8_MMA(0, 1, At, B1); PG8_BAR; PG8_SCHED;
            PG8_LDA(At, 1, 1); PG8_STAGE(PG8_SB(1, 0), b3, voffB); PG8_STAGE(PG8_SB(1, 1), b3 + hstep, voffB); PG8_STAGE(PG8_SA(1, 0), a3, voffA);
            PG8_WAIT_V(8); PG8_WAIT_L(0); PG8_BAR; PG8_MMA(1, 0, At, B0); PG8_MMA(1, 1, At, B1); PG8_BAR; PG8_SCHED;
            } else {
            PG8_LDB(B0, 0, 0); PG8_SCHED; PG8_LDA(At, 0, 0); PG8_STAGE(PG8_SA(1, 1), a1 + hstep, voffA);
            PG8_WAIT_L(8); PG8_BAR; PG8_WAIT_L(0); PG8_MMA(0, 0, At, B0); PG8_BAR; PG8_SCHED;
            PG8_LDB(B1, 0, 1); PG8_STAGE(PG8_SB(0, 0), b2, voffB);
            PG8_BAR; PG8_WAIT_L(0); PG8_MMA(0, 1, At, B1); PG8_BAR;
            PG8_LDA(At, 0, 1); PG8_STAGE(PG8_SA(0, 0), a2, voffA);
            PG8_BAR; PG8_WAIT_L(0); PG8_MMA(1, 0, At, B0); PG8_BAR; PG8_SCHED;
            PG8_STAGE(PG8_SB(0, 1), b2 + hstep, voffB);
            PG8_WAIT_V(6); PG8_BAR; PG8_MMA(1, 1, At, B1); PG8_BAR;
            PG8_LDB(B0, 1, 0); PG8_SCHED; PG8_LDA(At, 1, 0); PG8_STAGE(PG8_SA(0, 1), a2 + hstep, voffA);
            PG8_WAIT_L(8); PG8_BAR; PG8_WAIT_L(0); PG8_MMA(0, 0, At, B0); PG8_BAR; PG8_SCHED;
            PG8_LDB(B1, 1, 1); PG8_STAGE(PG8_SB(1, 0), b3, voffB);
            PG8_BAR; PG8_WAIT_L(0); PG8_MMA(0, 1, At, B1); PG8_BAR;
            PG8_LDA(At, 1, 1); PG8_STAGE(PG8_SA(1, 0), a3, voffA);
            PG8_BAR; PG8_WAIT_L(0); PG8_MMA(1, 0, At, B0); PG8_BAR; PG8_SCHED;
            PG8_STAGE(PG8_SB(1, 1), b3 + hstep, voffB);
            PG8_WAIT_V(6); PG8_BAR; PG8_MMA(1, 1, At, B1); PG8_BAR;
            }
        }
        if constexpr (ALIGN_EPI) { if (wr == 0) PG8_BAR; }
        if constexpr (!Epi::AFTER_DRAIN) { E(acc, cur, wr, wc, fr, fq); S.done(cur); }
        if (!has_next) break;
#pragma unroll
        for (int a = 0; a < 2; ++a)
#pragma unroll
            for (int b = 0; b < 2; ++b)
#pragma unroll
                for (int m = 0; m < 4; ++m)
#pragma unroll
                    for (int n = 0; n < 2; ++n) acc[a][b][m][n] = (f32x4){0.f, 0.f, 0.f, 0.f};
        cur = nxt; cA = nA; cB = nB; ++ui;
        if constexpr (ALIGN_EPI) { if (wr == 1) PG8_BAR; }
    }
    PG8_WAIT_V(0);
    if constexpr (!ALIGN_EPI) { if (wr == 0) PG8_BAR; }
    PG8_BAR;
    if constexpr (Epi::AFTER_DRAIN) { E.fused(acc, cur, wr, wc, fr, fq, lds, wid, lane); S.done(cur); }
#undef PG8_SA
#undef PG8_SB
#undef PG8_STAGE
#undef PG8_LDA
#undef PG8_LDB
#undef PG8_MMA
#undef PG8_WAIT_V
#undef PG8_WAIT_L
#undef PG8_BAR
#undef PG8_SCHED
}
}
constexpr int BATCH = 2, SEQ = 4096, DM = 2048, MTOK = BATCH * SEQ;
constexpr int NQH = 16, NKVH = 4, HD = 64, AW = 1024, KVW = 256, SW = 1024, SG = 64, SP = 64, SH = 16;
constexpr int DFF = 5632, OFF_K = 1024, OFF_V = 1280, OFF_U = 1536, OFF_G = 2560, ZW = 6656;
constexpr float LOG2E = 1.4426950408889634f;
#define LAS __attribute__((address_space(3)))
typedef unsigned short bf16;
typedef unsigned v4u __attribute__((ext_vector_type(4)));
typedef unsigned v2u __attribute__((ext_vector_type(2)));
typedef float f32x4 __attribute__((ext_vector_type(4)));
typedef float f32x16 __attribute__((ext_vector_type(16)));
typedef short bf16x8 __attribute__((ext_vector_type(8)));
#define LDS_WAIT() asm volatile("s_waitcnt lgkmcnt(0)" ::: "memory")
__device__ __forceinline__ unsigned pkbf(float lo, float hi) { unsigned r; asm volatile("v_cvt_pk_bf16_f32 %0, %1, %2" : "=v"(r) : "v"(lo), "v"(hi)); return r; }
__device__ __forceinline__ float bflo(unsigned w) { return __uint_as_float(w << 16); }
__device__ __forceinline__ float bfhi(unsigned w) { return __uint_as_float(w & 0xffff0000u); }
__device__ __forceinline__ void unpk8(const v4u w, float (&f)[8]) { f[0] = bflo(w.x); f[1] = bfhi(w.x); f[2] = bflo(w.y); f[3] = bfhi(w.y); f[4] = bflo(w.z); f[5] = bfhi(w.z); f[6] = bflo(w.w); f[7] = bfhi(w.w); }
__device__ __forceinline__ bf16x8 pk8v(const float (&f)[8]) { v4u w; w.x = pkbf(f[0], f[1]); w.y = pkbf(f[2], f[3]); w.z = pkbf(f[4], f[5]); w.w = pkbf(f[6], f[7]); return __builtin_bit_cast(bf16x8, w); }

namespace att {
constexpr int KP = 72, VP = 264;
constexpr int LDS_K = 0, LDS_V = 256 * KP * 2, LDS_END = LDS_V + 64 * VP * 2;
__device__ __forceinline__ void attn_unit(LAS unsigned char* lds, const bf16* __restrict__ Z, bf16* __restrict__ Y, const float* __restrict__ qg, const float* __restrict__ kg, const float* __restrict__ sinks, int b, int n, int kh) {
    int tid_ = threadIdx.x; asm volatile("" : "+v"(tid_));
    const int tid = tid_, lane = tid & 63, wid = __builtin_amdgcn_readfirstlane(tid >> 6);
    LAS bf16* Ks = (LAS bf16*)(lds + LDS_K); LAS bf16* Vt = (LAS bf16*)(lds + LDS_V);
    {
        const int c = tid & 7; float kgv[8];
#pragma unroll
        for (int i = 0; i < 8; ++i) kgv[i] = kg[8 * c + i];
#pragma unroll
        for (int ps = 0; ps < 4; ++ps) { const int key = ps * 64 + (tid >> 3); const int pos = 128 * n - 128 + key;
            v4u kw = (v4u){0u, 0u, 0u, 0u}, vw = (v4u){0u, 0u, 0u, 0u};
            if (pos >= 0) { const bf16* zr = Z + (size_t)(b * SEQ + pos) * ZW + 64 * kh + 8 * c; kw = *(const v4u*)(zr + OFF_K); vw = *(const v4u*)(zr + OFF_V); }
            float kf[8]; unpk8(kw, kf); float ss = 0.f;
#pragma unroll
            for (int i = 0; i < 8; ++i) ss += kf[i] * kf[i];
            ss += __shfl_xor(ss, 1); ss += __shfl_xor(ss, 2); ss += __shfl_xor(ss, 4);
            const float rs = rsqrtf(ss * (1.0f / 64.0f) + 1e-6f);
#pragma unroll
            for (int i = 0; i < 8; ++i) kf[i] = kf[i] * rs * kgv[i];
            *(LAS bf16x8*)(Ks + key * KP + 8 * c) = pk8v(kf);
            const unsigned vv[4] = {vw.x, vw.y, vw.z, vw.w};
#pragma unroll
            for (int i = 0; i < 4; ++i) { Vt[(8 * c + 2 * i) * VP + key] = (bf16)(vv[i] & 0xffffu); Vt[(8 * c + 2 * i + 1) * VP + key] = (bf16)(vv[i] >> 16); } }
    }
    __syncthreads();
    const int hq = 4 * kh + (wid >> 1), q = lane & 31, hi = lane >> 5;
    const float slope2 = exp2f(-0.5f * (float)(hq + 1)) * LOG2E, sink2 = sinks[hq] * LOG2E;
#pragma unroll 1
    for (int tile = 0; tile < 2; ++tile) {
        const int jq = 2 * (wid & 1) + tile; const size_t tok = (size_t)b * SEQ + 128 * n + 32 * jq + q;
        bf16x8 qf[4];
        {   float qv[4][8]; float ss = 0.f;
#pragma unroll
            for (int d0 = 0; d0 < 4; ++d0) { unpk8(*(const v4u*)(Z + tok * ZW + 64 * hq + 16 * d0 + 8 * hi), qv[d0]);
#pragma unroll
                for (int i = 0; i < 8; ++i) ss += qv[d0][i] * qv[d0][i]; }
            ss += __shfl_xor(ss, 32);
            const float rs = rsqrtf(ss * (1.0f / 64.0f) + 1e-6f) * (0.125f * LOG2E);
#pragma unroll
            for (int d0 = 0; d0 < 4; ++d0) {
#pragma unroll
                for (int i = 0; i < 8; ++i) qv[d0][i] = qv[d0][i] * rs * qg[16 * d0 + 8 * hi + i];
                qf[d0] = pk8v(qv[d0]); }
        }
        f32x16 s[5]; float mx = -INFINITY;
#pragma unroll
        for (int i = 0; i < 5; ++i) { const int kb = jq + i; const bool ok = !(n == 0 && kb < 4);
            if (ok) { f32x16 a = {};
#pragma unroll
                for (int d0 = 0; d0 < 4; ++d0) { const bf16x8 kfr = *(const LAS bf16x8*)(Ks + (32 * kb + q) * KP + 16 * d0 + 8 * hi); a = __builtin_amdgcn_mfma_f32_32x32x16_bf16(kfr, qf[d0], a, 0, 0, 0); }
#pragma unroll
                for (int r = 0; r < 16; ++r) { const int keyrow = (r & 3) + 8 * (r >> 2) + 4 * hi; const int dist = q + 128 - 32 * i - keyrow;
                    const float v = a[r] - slope2 * (float)dist; a[r] = (dist >= 0 && dist < 128) ? v : -INFINITY; mx = fmaxf(mx, a[r]); }
                s[i] = a;
            } else {
#pragma unroll
                for (int r = 0; r < 16; ++r) s[i][r] = -INFINITY; } }
        mx = fmaxf(mx, __shfl_xor(mx, 32)); mx = fmaxf(mx, sink2);
        float lsum = 0.f;
#pragma unroll
        for (int i = 0; i < 5; ++i)
#pragma unroll
            for (int r = 0; r < 16; ++r) { s[i][r] = __builtin_amdgcn_exp2f(s[i][r] - mx); lsum += s[i][r]; }
        lsum += __shfl_xor(lsum, 32);
        const float inv = 1.0f / (lsum + __builtin_amdgcn_exp2f(sink2 - mx));
        f32x16 o[2]; o[0] = f32x16{}; o[1] = f32x16{};
#pragma unroll
        for (int i = 0; i < 5; ++i) { const int kb = jq + i; const bool ok = !(n == 0 && kb < 4);
            if (ok) {
#pragma unroll
                for (int ks = 0; ks < 2; ++ks) { float pv[8];
#pragma unroll
                    for (int j = 0; j < 8; ++j) pv[j] = s[i][8 * ks + j];
                    const bf16x8 pa = pk8v(pv);
#pragma unroll
                    for (int db = 0; db < 2; ++db) { const LAS bf16* vp = Vt + (32 * db + q) * VP + 32 * kb + 16 * ks + 4 * hi;
                        const v2u lo = *(const LAS v2u*)vp, hi2 = *(const LAS v2u*)(vp + 8); const v4u vw = (v4u){lo.x, lo.y, hi2.x, hi2.y};
                        o[db] = __builtin_amdgcn_mfma_f32_32x32x16_bf16(__builtin_bit_cast(bf16x8, vw), pa, o[db], 0, 0, 0); } } } }
        bf16* yr = Y + tok * AW + 64 * hq + 4 * hi;
#pragma unroll
        for (int db = 0; db < 2; ++db)
#pragma unroll
            for (int rq = 0; rq < 4; ++rq) { v2u w; w.x = pkbf(o[db][4 * rq] * inv, o[db][4 * rq + 1] * inv); w.y = pkbf(o[db][4 * rq + 2] * inv, o[db][4 * rq + 3] * inv); *(v2u*)(yr + 32 * db + 8 * rq) = w; }
    }
    __syncthreads();
}
}

namespace ssm {
constexpr int BUP = 20, SXP = 144;
constexpr int WAVE_BYTES = 128 * BUP * 4 + 16 * SXP * 2, CARRY_OFF = 8 * WAVE_BYTES, LDS_END = CARRY_OFF + 8 * 128 * 4;
__device__ __forceinline__ float gelu_tanh(float v) { const float t = 0.7978845608028654f * (v + 0.044715f * v * v * v); const float e = __builtin_amdgcn_exp2f(-2.0f * LOG2E * t); return v * __builtin_amdgcn_rcpf(1.0f + e); }
struct Params { const float *lam_re, *lam_im, *log_dt, *b_re, *b_im, *c_re, *c_im, *dsk; };
__device__ __forceinline__ void zoh(const Params& P, int g, int p, float dt, float& ar, float& ai, float& fr, float& fi) {
    const float lr = P.lam_re[g * SP + p], li = P.lam_im[g * SP + p]; const float mag = expf(lr * dt); float sn, cs; sn = sinf(li * dt); cs = cosf(li * dt);
    ar = mag * cs; ai = mag * sn; const float den = lr * lr + li * li; fr = ((ar - 1.0f) * lr + ai * li) / den; fi = (ai * lr - (ar - 1.0f) * li) / den;
}
__device__ __forceinline__ void ssm_unit(LAS unsigned char* lds, const bf16* __restrict__ Z, bf16* __restrict__ YG, const Params P, int b, int g) {
    int tid_ = threadIdx.x; asm volatile("" : "+v"(tid_));
    const int tid = tid_, lane = tid & 63, wid = __builtin_amdgcn_readfirstlane(tid >> 6), l31 = lane & 31, hi = lane >> 5, l15 = lane & 15, lq = lane >> 4;
    LAS float* bu = (LAS float*)(lds + wid * WAVE_BYTES); LAS bf16* sx = (LAS bf16*)(lds + wid * WAVE_BYTES + 128 * BUP * 4); LAS float* carry = (LAS float*)(lds + CARRY_OFF);
    const float dt = expf(P.log_dt[g]);
    float ar, ai; { float fr_, fi_; zoh(P, g, lane, dt, ar, ai, fr_, fi_); }
    bf16x8 bfrag[4];
#pragma unroll
    for (int h2 = 0; h2 < 2; ++h2) { const int ps = 32 * h2 + l31; float ar2, ai2, fr, fi; zoh(P, g, ps, dt, ar2, ai2, fr, fi);
        float br[8], bi[8], vr[8], vi[8];
#pragma unroll
        for (int i = 0; i < 8; ++i) { br[i] = P.b_re[(g * SP + ps) * SH + 8 * hi + i]; bi[i] = P.b_im[(g * SP + ps) * SH + 8 * hi + i]; vr[i] = fr * br[i] - fi * bi[i]; vi[i] = fr * bi[i] + fi * br[i]; }
        bfrag[h2] = pk8v(vr); bfrag[2 + h2] = pk8v(vi); }
    bf16x8 cfrag[4];
#pragma unroll
    for (int kk = 0; kk < 4; ++kk) { float cv[8];
#pragma unroll
        for (int i = 0; i < 8; ++i) { const int idx = (g * SH + l15) * SP + 32 * (kk & 1) + 8 * lq + i; cv[i] = kk < 2 ? P.c_re[idx] : -P.c_im[idx]; }
        cfrag[kk] = pk8v(cv); }
    float dsk[4];
#pragma unroll
    for (int i = 0; i < 4; ++i) dsk[i] = P.dsk[g * SH + 4 * lq + i];
    const size_t tok0 = (size_t)b * SEQ + 512 * wid;
    const bf16* ubase = Z + tok0 * ZW + OFF_U + SH * g;
    float s_r = 0.f, s_i = 0.f;
#pragma unroll 1
    for (int pass = 0; pass < 2; ++pass) {
        v4u unext = *(const v4u*)(ubase + (size_t)l31 * ZW + 8 * hi);
#pragma unroll 1
        for (int ch = 0; ch < 16; ++ch) {
            const v4u ucur = unext;
            if (ch + 1 < 16) unext = *(const v4u*)(ubase + (size_t)(32 * (ch + 1) + l31) * ZW + 8 * hi);
            f32x16 c[4];
#pragma unroll
            for (int j = 0; j < 4; ++j) c[j] = __builtin_amdgcn_mfma_f32_32x32x16_bf16(__builtin_bit_cast(bf16x8, ucur), bfrag[j], f32x16{}, 0, 0, 0);
#pragma unroll
            for (int half = 0; half < 2; ++half) {
                v2u ue = (v2u){0u, 0u};
                if (pass == 1) ue = *(const v2u*)(ubase + (size_t)(32 * ch + 16 * half + l15) * ZW + 4 * lq);
#pragma unroll
                for (int j = 0; j < 4; ++j)
#pragma unroll
                    for (int qq = 0; qq < 2; ++qq) { const int r0 = 4 * (2 * half + qq); *(LAS f32x4*)(bu + (32 * j + l31) * BUP + 8 * qq + 4 * hi) = (f32x4){c[j][r0], c[j][r0 + 1], c[j][r0 + 2], c[j][r0 + 3]}; }
                LDS_WAIT();
                f32x4 xr[4], xi[4];
#pragma unroll
                for (int k = 0; k < 4; ++k) { xr[k] = *(const LAS f32x4*)(bu + lane * BUP + 4 * k); xi[k] = *(const LAS f32x4*)(bu + (64 + lane) * BUP + 4 * k); }
                LDS_WAIT();
#pragma unroll
                for (int t = 0; t < 16; ++t) { const float nr = ar * s_r - ai * s_i + xr[t >> 2][t & 3], ni = ar * s_i + ai * s_r + xi[t >> 2][t & 3]; s_r = nr; s_i = ni;
                    if (pass == 1) { const unsigned w = pkbf(s_r, s_i); sx[t * SXP + lane] = (bf16)(w & 0xffffu); sx[t * SXP + 64 + lane] = (bf16)(w >> 16); } }
                if (pass == 1) {
                    LDS_WAIT();
                    f32x4 y = {0.f, 0.f, 0.f, 0.f};
#pragma unroll
                    for (int kk = 0; kk < 4; ++kk) { const bf16x8 sf = *(const LAS bf16x8*)(sx + l15 * SXP + 32 * kk + 8 * lq); y = __builtin_amdgcn_mfma_f32_16x16x32_bf16(cfrag[kk], sf, y, 0, 0, 0); }
                    LDS_WAIT();
                    const float u0 = bflo(ue.x), u1 = bfhi(ue.x), u2 = bflo(ue.y), u3 = bfhi(ue.y);
                    v2u w; w.x = pkbf(gelu_tanh(y[0] + dsk[0] * u0), gelu_tanh(y[1] + dsk[1] * u1)); w.y = pkbf(gelu_tanh(y[2] + dsk[2] * u2), gelu_tanh(y[3] + dsk[3] * u3));
                    *(v2u*)(YG + (tok0 + 32 * ch + 16 * half + l15) * SW + SH * g + 4 * lq) = w;
                }
            }
        }
        if (pass == 0) {
            carry[wid * 128 + lane] = s_r; carry[wid * 128 + 64 + lane] = s_i;
            __syncthreads();
            float pr = ar, pi = ai;
#pragma unroll
            for (int k = 0; k < 9; ++k) { const float nr = pr * pr - pi * pi, ni = 2.0f * pr * pi; pr = nr; pi = ni; }
            s_r = 0.f; s_i = 0.f;
            for (int j = 0; j < wid; ++j) { const float er = carry[j * 128 + lane], ei = carry[j * 128 + 64 + lane]; const float nr = pr * s_r - pi * s_i + er, ni = pr * s_i + pi * s_r + ei; s_r = nr; s_i = ni; }
        }
    }
    __syncthreads();
}
}
#ifndef SKIP_P0
#define SKIP_P0 0
#endif
#ifndef SKIP_SSM
#define SKIP_SSM 0
#endif
#ifndef SKIP_ATT
#define SKIP_ATT 0
#endif
constexpr int NWAVES = 8, NTHR = NWAVES * 64, NLAYER = 2;
#ifndef MK_N_LAUNCHES
#define MK_N_LAUNCHES 1
#endif
constexpr size_t MiB = 1u << 20;
constexpr size_t WS_CTL = 0, CTL_ZERO_BYTES = 1 * MiB;
constexpr size_t WL_WIN = 0, WL_GLU = WL_WIN + (size_t)ZW * DM * 2, WL_WAB = WL_GLU + (size_t)SW * SW * 2, WL_WSB = WL_WAB + (size_t)DM * AW * 2, WL_WOUT = WL_WSB + (size_t)DM * SW * 2,
                 WL_WFI = WL_WOUT + (size_t)DM * DM * 2, WL_WFO = WL_WFI + (size_t)2 * DFF * DM * 2, WL_SIZE = WL_WFO + (size_t)DM * DFF * 2;
constexpr size_t WS_W = 1 * MiB, WS_XB = WS_W + NLAYER * WL_SIZE, WS_Z = WS_XB + (size_t)MTOK * DM * 2, WS_YA = WS_Z + (size_t)MTOK * ZW * 2, WS_YG = WS_YA + (size_t)MTOK * AW * 2,
                 WS_YS = WS_YG + (size_t)MTOK * SW * 2, WS_T1 = WS_YS + (size_t)MTOK * SW * 2, WS_MG = WS_T1 + (size_t)MTOK * DM * 4, WS_X1 = WS_MG + (size_t)MTOK * DM * 2, WS_END = WS_X1 + (size_t)MTOK * DM * 4;
constexpr size_t WS_ACT = WS_Z;
static_assert((size_t)MTOK * DFF * 2 <= (size_t)MTOK * ZW * 2, "act overlays z");
constexpr int LDS_BYTES = 147456;
static_assert(att::LDS_END <= 131072 && ssm::LDS_END <= 131072, "phase scratch fits the stage region");

struct Args { const float* in[23]; float* out; unsigned char* ws; int ph_lo, ph_hi; };

__device__ __forceinline__ void transpose_item(const float* __restrict__ W, int K, int N, const float* __restrict__ rsc, bf16* __restrict__ WT, bool swi, LAS float* scr, int item, int lane) {
    const int nblk = N / 64, kb = item / nblk, nb = item % nblk, k0 = 64 * kb, n0 = 64 * nb;
    const int c4 = lane & 15, r4 = lane >> 4;
    f32x4 v[16];
#pragma unroll
    for (int i = 0; i < 16; ++i) v[i] = *(const f32x4*)(W + (size_t)(k0 + 4 * i + r4) * N + n0 + 4 * c4);
#pragma unroll
    for (int i = 0; i < 16; ++i) { const int kk = 4 * i + r4; const float sc = rsc ? rsc[k0 + kk] : 1.0f; LAS float* d = scr + kk * 65 + 4 * c4; d[0] = v[i][0] * sc; d[1] = v[i][1] * sc; d[2] = v[i][2] * sc; d[3] = v[i][3] * sc; }
    LDS_WAIT();
    int d0 = n0;
    if (swi) { d0 = (n0 < DFF) ? (256 * (n0 / 128) + (n0 % 128)) : (256 * ((n0 - DFF) / 128) + 128 + ((n0 - DFF) % 128)); }
    const int c = lane & 7;
#pragma unroll
    for (int j = 0; j < 8; ++j) { const int n = (lane >> 3) + 8 * j; const LAS float* s = scr + (8 * c) * 65 + n;
        v4u o; o.x = pkbf(s[0], s[65]); o.y = pkbf(s[2 * 65], s[3 * 65]); o.z = pkbf(s[4 * 65], s[5 * 65]); o.w = pkbf(s[6 * 65], s[7 * 65]);
        *(v4u*)(WT + (size_t)(d0 + n) * K + k0 + 8 * c) = o; }
    LDS_WAIT();
}
__device__ __forceinline__ float wave_sum(float v) {
#pragma unroll
    for (int o = 1; o < 64; o <<= 1) v += __shfl_xor(v, o);
    return v;
}

__global__ void __launch_bounds__(NTHR, 2) fwd_kernel(Args args) {
    extern __shared__ __attribute__((aligned(16))) unsigned char lds_raw[];
    LAS unsigned char* lds = (LAS unsigned char*)lds_raw;
    cg::grid_group grid = cg::this_grid();
    const int tid = threadIdx.x, lane = tid & 63, wave = __builtin_amdgcn_readfirstlane(tid >> 6), G = gridDim.x, bx = blockIdx.x;
    unsigned char* ws = args.ws;
    float* ssq = (float*)(ws + WS_CTL);
    bf16* XB = (bf16*)(ws + WS_XB); bf16* Zb = (bf16*)(ws + WS_Z); bf16* YA = (bf16*)(ws + WS_YA); bf16* YG = (bf16*)(ws + WS_YG); bf16* YS = (bf16*)(ws + WS_YS);
    float* T1 = (float*)(ws + WS_T1); bf16* MG = (bf16*)(ws + WS_MG); float* X1 = (float*)(ws + WS_X1); bf16* ACT = (bf16*)(ws + WS_ACT);
    const float* x_in = args.in[0];
    const int lo = args.ph_lo, hi = args.ph_hi; int ph = 0;
#define IN_PH (lo <= ph && ph < hi)
#define SEAM() do { if (lo <= ph && ph + 1 < hi) grid.sync(); ++ph; } while (0)

    if (IN_PH && !SKIP_P0) {
        LAS float* scr = (LAS float*)(lds + wave * (64 * 65 * 4));
        const int gw = bx * NWAVES + wave, NGW = G * NWAVES;
        struct WD { int in_idx, K, N, gain_idx; size_t off; bool swi; };
        const WD wd[7] = {{2, DM, ZW, 1, WL_WIN, false}, {15, SW, SW, -1, WL_GLU, false}, {17, AW, DM, -1, WL_WAB, false}, {18, SW, DM, -1, WL_WSB, false},
                          {19, DM, DM, -1, WL_WOUT, false}, {21, DM, 2 * DFF, 20, WL_WFI, true}, {22, DFF, DM, -1, WL_WFO, false}};
#pragma unroll 1
        for (int l = 0; l < NLAYER; ++l)
#pragma unroll
            for (int w = 0; w < 7; ++w) { const int K = wd[w].K, N = wd[w].N; const int nit = (K / 64) * (N / 64);
                const float* W = args.in[wd[w].in_idx] + (size_t)l * K * N; const float* rsc = wd[w].gain_idx >= 0 ? args.in[wd[w].gain_idx] + (size_t)l * K : nullptr;
                bf16* WT = (bf16*)(ws + WS_W + l * WL_SIZE + wd[w].off);
#pragma unroll 1
                for (int it = gw; it < nit; it += NGW) transpose_item(W, K, N, rsc, WT, wd[w].swi, scr, it, lane); }
#pragma unroll 1
        for (int m = gw; m < MTOK; m += NGW) { const f32x4* xr = (const f32x4*)(x_in + (size_t)m * DM) + lane; f32x4 v[8]; float s = 0.f;
#pragma unroll
            for (int j = 0; j < 8; ++j) { v[j] = xr[64 * j]; s += (v[j][0] * v[j][0] + v[j][1] * v[j][1]) + (v[j][2] * v[j][2] + v[j][3] * v[j][3]); }
            s = wave_sum(s); if (lane == 0) ssq[m] = s;
            v2u* o = (v2u*)(XB + (size_t)m * DM) + lane;
#pragma unroll
            for (int j = 0; j < 8; ++j) { v2u w; w.x = pkbf(v[j][0], v[j][1]); w.y = pkbf(v[j][2], v[j][3]); o[64 * j] = w; } }
        __syncthreads();
    }
    SEAM();
#pragma unroll 1
    for (int l = 0; l < NLAYER; ++l) {
        const unsigned char* wl = ws + WS_W + l * WL_SIZE;
        const bf16* Win = (const bf16*)(wl + WL_WIN); const bf16* Wglu = (const bf16*)(wl + WL_GLU); const bf16* Wab = (const bf16*)(wl + WL_WAB); const bf16* Wsb = (const bf16*)(wl + WL_WSB);
        const bf16* Wout = (const bf16*)(wl + WL_WOUT); const bf16* Wfi = (const bf16*)(wl + WL_WFI); const bf16* Wfo = (const bf16*)(wl + WL_WFO);
        float* ssqA = ssq + (size_t)(2 * l) * MTOK; float* ssqB = ssq + (size_t)(2 * l + 1) * MTOK; float* ssqN = (l + 1 < NLAYER) ? ssq + (size_t)(2 * l + 2) * MTOK : nullptr;
        const float* xres = (l == 0) ? x_in : args.out;
        if (IN_PH) {
            pg8::Gemm g{XB, Win, MTOK, ZW, DM}; pg8::StaticOrder S; S.init(MTOK, ZW, G, bx);
            pg8::EpiWin E{Zb, ZW, ssqA, args.in[3] + (size_t)l * 2 * DM, OFF_G / 256, 1.0f / DM};
            pg8::gemm_phase<pg8::EpiWin, pg8::StaticOrder, true, true>(lds, g, S, E);
        }
        SEAM();
        if (IN_PH) {
            const int nS = G >= 2 ? G / 2 : 1;
            if (!SKIP_SSM && (bx < nS || G < 2)) {
                const ssm::Params P{args.in[7] + (size_t)l * SG * SP, args.in[8] + (size_t)l * SG * SP, args.in[9] + (size_t)l * SG, args.in[10] + (size_t)l * SG * SP * SH, args.in[11] + (size_t)l * SG * SP * SH,
                                    args.in[12] + (size_t)l * SG * SH * SP, args.in[13] + (size_t)l * SG * SH * SP, args.in[14] + (size_t)l * SW};
#pragma unroll 1
                for (int u = bx; u < BATCH * SG; u += nS) ssm::ssm_unit(lds, Zb, YG, P, u / SG, u % SG);
            }
            if (!SKIP_ATT && (bx >= nS || G < 2)) {
                const int a0 = G < 2 ? 0 : bx - nS, na = G < 2 ? 1 : G - nS;
#pragma unroll 1
                for (int u = a0; u < BATCH * 32 * NKVH; u += na) att::attn_unit(lds, Zb, YA, args.in[4] + l * HD, args.in[5] + l * HD, args.in[6] + l * NQH, u / (32 * NKVH), (u / NKVH) % 32, u % NKVH);
            }
        }
        SEAM();
        if (IN_PH) {
            { pg8::Gemm g{YA, Wab, MTOK, DM, AW}; pg8::StaticOrder S; S.init(MTOK, DM, G, bx);
              pg8::EpiGateMerge<true> E{T1, nullptr, DM, Zb + OFF_G, ZW};
              pg8::gemm_phase<pg8::EpiGateMerge<true>, pg8::StaticOrder, true, true>(lds, g, S, E); }
            { pg8::Gemm g{YG, Wglu, MTOK, SW, SW}; pg8::StaticOrder S; S.init(MTOK, SW, G, bx);
              pg8::EpiGlu E{YS, YG, SW, args.in[16] + (size_t)l * SW};
              pg8::gemm_phase<pg8::EpiGlu, pg8::StaticOrder, true, true>(lds, g, S, E); }
        }
        SEAM();
        if (IN_PH) {
            pg8::Gemm g{YS, Wsb, MTOK, DM, SW}; pg8::StaticOrder S; S.init(MTOK, DM, G, bx);
            pg8::EpiGateMerge<false> E{T1, MG, DM, Zb + OFF_G + DM, ZW};
            pg8::gemm_phase<pg8::EpiGateMerge<false>, pg8::StaticOrder, true, true>(lds, g, S, E);
        }
        SEAM();
        if (IN_PH) {
            pg8::Gemm g{MG, Wout, MTOK, DM, DM}; pg8::StaticOrder S; S.init(MTOK, DM, G, bx);
            pg8::EpiResid E{xres, X1, XB, DM, ssqB};
            pg8::gemm_phase<pg8::EpiResid, pg8::StaticOrder, true, true>(lds, g, S, E);
        }
        SEAM();
        if (IN_PH) {
            pg8::Gemm g{XB, Wfi, MTOK, 2 * DFF, DM}; pg8::StaticOrder S; S.init(MTOK, 2 * DFF, G, bx);
            pg8::EpiSwiglu E{ACT, DFF, ssqB, 1.0f / DM};
            pg8::gemm_phase<pg8::EpiSwiglu, pg8::StaticOrder, true, true>(lds, g, S, E);
        }
        SEAM();
        if (IN_PH) {
            pg8::Gemm g{ACT, Wfo, MTOK, DM, DFF}; pg8::StaticOrder S; S.init(MTOK, DM, G, bx);
            pg8::EpiResid E{X1, args.out, XB, DM, ssqN};
            pg8::gemm_phase<pg8::EpiResid, pg8::StaticOrder, true, true>(lds, g, S, E);
        }
        SEAM();
    }
#undef IN_PH
#undef SEAM
}
constexpr int N_PHASES = 1 + 7 * NLAYER;

extern "C" void kernel_launch(void* const* d_in, const int* in_sizes, int n_in, void* d_out, int out_size, void* d_ws, size_t ws_size, hipStream_t stream) {
    static int grid = 0;
    if (grid == 0) {
        if (n_in != 23 || in_sizes[0] != MTOK * DM || out_size != MTOK * DM || ws_size < WS_END) { fprintf(stderr, "kernel_launch: unexpected shapes (n_in %d, ws %zu < %zu?)\n", n_in, ws_size, (size_t)WS_END); grid = -1; return; }
        int dev = 0, cus = 0, per_cu = 0;
        hipGetDevice(&dev); hipDeviceGetAttribute(&cus, hipDeviceAttributeMultiprocessorCount, dev);
        hipFuncSetAttribute((const void*)fwd_kernel, hipFuncAttributeMaxDynamicSharedMemorySize, LDS_BYTES);
        hipOccupancyMaxActiveBlocksPerMultiprocessor(&per_cu, (const void*)fwd_kernel, NTHR, LDS_BYTES);
        if (per_cu < 1) { fprintf(stderr, "kernel_launch: occupancy query says %d blocks per CU\n", per_cu); per_cu = 1; }
        (void)hipGetLastError();
        grid = cus;
    }
    if (grid < 0) return;
    hipMemsetAsync((char*)d_ws + WS_CTL, 0, CTL_ZERO_BYTES, stream);
    Args a{};
    for (int i = 0; i < 23; ++i) a.in[i] = (const float*)d_in[i];
    a.out = (float*)d_out; a.ws = (unsigned char*)d_ws;
    const int nl = MK_N_LAUNCHES;
    for (int li = 0; li < nl; ++li) {
        a.ph_lo = (nl == 1) ? 0 : li; a.ph_hi = (nl == 1) ? N_PHASES : li + 1;
        void* kargs[] = {&a};
        hipError_t e = hipLaunchCooperativeKernel((const void*)fwd_kernel, dim3(grid), dim3(NTHR), kargs, LDS_BYTES, stream);
        if (e != hipSuccess) { fprintf(stderr, "kernel_launch: cooperative launch %d failed: %s (grid %d)\n", li, hipGetErrorString(e), grid); break; }
    }
}
```

```cpp
#include <hip/hip_runtime.h>
#include <hip/hip_cooperative_groups.h>
#include <cstdio>
#include <cstdint>
#include <cmath>
namespace cg = cooperative_groups;
namespace pg8 {
#define PG8_LAS __attribute__((address_space(3)))
typedef unsigned short bf16_t;
typedef short bf16x8 __attribute__((ext_vector_type(8)));
typedef float f32x4 __attribute__((ext_vector_type(4)));
typedef unsigned u32x4 __attribute__((ext_vector_type(4)));
constexpr int BM = 256, BK = 64, HALF = 128, HTB = HALF * BK * 2  , STAGE_BYTES = 8 * HTB, NXCD = 8, WGM = 8;

__host__ __device__ __forceinline__ int lds_byte(int r, int c) { const int st = (r >> 4) * 2 + (c >> 5), rr = r & 15, cc = c & 31, ob = rr * 64 + cc * 2; return st * 1024 + (ob ^ (((ob >> 9) & 1) << 5)); }
__host__ __device__ __forceinline__ void stage_rc(int b, int& R, int& C) { const int st = b / 1024, sb = b % 1024, swz = sb ^ (((sb >> 9) & 1) << 5); R = (st >> 1) * 16 + swz / 64; C = (st & 1) * 32 + (swz % 64) / 2; }
__host__ __device__ __forceinline__ int perm32(int rho) { const int n = rho >> 4, i = rho & 15; return 8 * (i >> 2) + 4 * n + (i & 3); }

struct Unit { int pm, pn; };
struct Gemm { const bf16_t* A; const bf16_t* Bt; int M, N, K; };

struct StaticOrder {
    int nM, nN, nwg, G, c;
    __host__ __device__ void init(int M, int N, int G_, int c_) { nM = M / BM; nN = N / BM; nwg = nM * nN; G = G_; c = c_; }
    __host__ __device__ bool next(int i, Unit& u) const {
        const long L = (long)i * G + c; if (L >= nwg) return false;
        int wgid = (int)L; { const int q = nwg / NXCD, r = nwg % NXCD, xcd = wgid % NXCD, off = wgid / NXCD; wgid = (xcd < r ? xcd * (q + 1) : r * (q + 1) + (xcd - r) * q) + off; }
        const int nig = WGM * nN, gid = wgid / nig, fm = gid * WGM, gsz = (nM - fm) < WGM ? (nM - fm) : WGM;
        u.pm = fm + ((wgid % nig) % gsz); u.pn = (wgid % nig) / gsz; return true;
    }
    __device__ __forceinline__ void a_ready(const Unit&) const {}
    __device__ __forceinline__ void done(const Unit&) const {}
};

__device__ __forceinline__ unsigned cvt_pk_bf16(float lo, float hi) { unsigned r; asm volatile("v_cvt_pk_bf16_f32 %0, %1, %2" : "=v"(r) : "v"(lo), "v"(hi)); return r; }
typedef float f32x2 __attribute__((ext_vector_type(2)));
__device__ __forceinline__ f32x2 gelu_pk(f32x2 v) {
    const f32x2 av = __builtin_elementwise_abs(v), d = av * 0.2316418882f + 1.0f;
    f32x2 t; t.x = __builtin_amdgcn_rcpf(d.x); t.y = __builtin_amdgcn_rcpf(d.y);
    f32x2 q = t * 0.5307027145f + (-0.7265760135f); q = q * t + 0.7107068705f; q = q * t + (-0.142248368f); q = q * t + 0.127414796f; q = q * t;
    const f32x2 s = (v * v) * (-0.72134752044f);
    f32x2 e; e.x = __builtin_amdgcn_exp2f(s.x); e.y = __builtin_amdgcn_exp2f(s.y);
    const f32x2 m = v * (q * e), r = v - m;
    f32x2 o; o.x = v.x < 0.f ? m.x : r.x; o.y = v.y < 0.f ? m.y : r.y; return o;
}

constexpr float RMS_EPS_F = 1e-6f;
__device__ __forceinline__ float sigm(float v) { return __builtin_amdgcn_rcpf(1.0f + __builtin_amdgcn_exp2f(-1.4426950408889634f * v)); }
__device__ __forceinline__ float bf_lo(unsigned w) { return __uint_as_float(w << 16); }
__device__ __forceinline__ float bf_hi(unsigned w) { return __uint_as_float(w & 0xffff0000u); }
__device__ __forceinline__ void unpack8(const u32x4 w, float (&f)[8]) { f[0] = bf_lo(w.x); f[1] = bf_hi(w.x); f[2] = bf_lo(w.y); f[3] = bf_hi(w.y); f[4] = bf_lo(w.z); f[5] = bf_hi(w.z); f[6] = bf_lo(w.w); f[7] = bf_hi(w.w); }
__device__ __forceinline__ u32x4 pack8(const float (&f)[8]) { u32x4 w; w.x = cvt_pk_bf16(f[0], f[1]); w.y = cvt_pk_bf16(f[2], f[3]); w.z = cvt_pk_bf16(f[4], f[5]); w.w = cvt_pk_bf16(f[6], f[7]); return w; }
#define EPI_LOOP_ROWS for (int ai = 0; ai < 2; ++ai) _Pragma("unroll") for (int m = 0; m < 4; ++m)

struct EpiWin {
    static constexpr bool PERM = true, AFTER_DRAIN = false;
    bf16_t* Z; int ldz; const float* ssq; const float* gbias; int gate_pn0; float inv_d;
    __device__ __forceinline__ void operator()(const f32x4 (&acc)[2][2][4][2], const Unit& u, int wr, int wc, int fr, int fq) const {
        const int row0 = u.pm * BM + wr * 64 + fr, col0 = u.pn * BM + wc * 32 + 8 * fq;
        const bool gate = u.pn >= gate_pn0;
        f32x4 bv[2][2];
#pragma unroll
        for (int bj = 0; bj < 2; ++bj)
#pragma unroll
            for (int n = 0; n < 2; ++n) bv[bj][n] = gate ? *(const f32x4*)(gbias + (col0 - gate_pn0 * BM) + bj * HALF + 4 * n) : (f32x4){0.f, 0.f, 0.f, 0.f};
#pragma unroll
        EPI_LOOP_ROWS { const int row = row0 + ai * HALF + m * 16; const float rs = rsqrtf(ssq[row] * inv_d + RMS_EPS_F); bf16_t* rowp = Z + (size_t)row * ldz + col0;
#pragma unroll
            for (int bj = 0; bj < 2; ++bj) { f32x4 v0 = acc[ai][bj][m][0] * rs, v1 = acc[ai][bj][m][1] * rs;
                if (gate) { v0 += bv[bj][0]; v1 += bv[bj][1];
#pragma unroll
                    for (int j = 0; j < 4; ++j) { v0[j] = sigm(v0[j]); v1[j] = sigm(v1[j]); } }
                u32x4 w; w.x = cvt_pk_bf16(v0[0], v0[1]); w.y = cvt_pk_bf16(v0[2], v0[3]); w.z = cvt_pk_bf16(v1[0], v1[1]); w.w = cvt_pk_bf16(v1[2], v1[3]);
                *(u32x4*)(rowp + bj * HALF) = w; } }
    }
};
struct EpiGlu {
    static constexpr bool PERM = true, AFTER_DRAIN = false;
    bf16_t* O; const bf16_t* YG; int ld; const float* bias;
    __device__ __forceinline__ void operator()(const f32x4 (&acc)[2][2][4][2], const Unit& u, int wr, int wc, int fr, int fq) const {
        const int row0 = u.pm * BM + wr * 64 + fr, col0 = u.pn * BM + wc * 32 + 8 * fq;
        f32x4 bv[2][2];
#pragma unroll
        for (int bj = 0; bj < 2; ++bj)
#pragma unroll
            for (int n = 0; n < 2; ++n) bv[bj][n] = *(const f32x4*)(bias + col0 + bj * HALF + 4 * n);
#pragma unroll
        EPI_LOOP_ROWS { const size_t off = (size_t)(row0 + ai * HALF + m * 16) * ld + col0;
#pragma unroll
            for (int bj = 0; bj < 2; ++bj) { const f32x4 v0 = acc[ai][bj][m][0] + bv[bj][0], v1 = acc[ai][bj][m][1] + bv[bj][1];
                float y[8]; unpack8(*(const u32x4*)(YG + off + bj * HALF), y); float o[8];
#pragma unroll
                for (int j = 0; j < 4; ++j) { o[j] = y[j] * sigm(v0[j]); o[4 + j] = y[4 + j] * sigm(v1[j]); }
                *(u32x4*)(O + off + bj * HALF) = pack8(o); } }
    }
};
template <bool FIRST> struct EpiGateMerge {
    static constexpr bool PERM = true, AFTER_DRAIN = false;
    float* T; bf16_t* O; int ld; const bf16_t* G; int ldg;
    __device__ __forceinline__ void operator()(const f32x4 (&acc)[2][2][4][2], const Unit& u, int wr, int wc, int fr, int fq) const {
        const int row0 = u.pm * BM + wr * 64 + fr, col0 = u.pn * BM + wc * 32 + 8 * fq;
#pragma unroll
        EPI_LOOP_ROWS { const int row = row0 + ai * HALF + m * 16; const size_t off = (size_t)row * ld + col0; const size_t goff = (size_t)row * ldg + col0;
#pragma unroll
            for (int bj = 0; bj < 2; ++bj) { float g[8]; unpack8(*(const u32x4*)(G + goff + bj * HALF), g);
                f32x4 v0 = acc[ai][bj][m][0], v1 = acc[ai][bj][m][1];
#pragma unroll
                for (int j = 0; j < 4; ++j) { v0[j] *= g[j]; v1[j] *= g[4 + j]; }
                if (FIRST) { *(f32x4*)(T + off + bj * HALF) = v0; *(f32x4*)(T + off + bj * HALF + 4) = v1; }
                else { v0 += *(const f32x4*)(T + off + bj * HALF); v1 += *(const f32x4*)(T + off + bj * HALF + 4);
                    u32x4 w; w.x = cvt_pk_bf16(v0[0], v0[1]); w.y = cvt_pk_bf16(v0[2], v0[3]); w.z = cvt_pk_bf16(v1[0], v1[1]); w.w = cvt_pk_bf16(v1[2], v1[3]);
                    *(u32x4*)(O + off + bj * HALF) = w; } } }
    }
};
struct EpiResid {
    static constexpr bool PERM = true, AFTER_DRAIN = false;
    const float* res; float* out; bf16_t* outb; int ld; float* ssq_out;
    __device__ __forceinline__ void operator()(const f32x4 (&acc)[2][2][4][2], const Unit& u, int wr, int wc, int fr, int fq) const {
        const int row0 = u.pm * BM + wr * 64 + fr, col0 = u.pn * BM + wc * 32 + 8 * fq;
#pragma unroll
        EPI_LOOP_ROWS { const int row = row0 + ai * HALF + m * 16; const size_t off = (size_t)row * ld + col0; float s = 0.f;
#pragma unroll
            for (int bj = 0; bj < 2; ++bj) {
                const f32x4 v0 = acc[ai][bj][m][0] + *(const f32x4*)(res + off + bj * HALF), v1 = acc[ai][bj][m][1] + *(const f32x4*)(res + off + bj * HALF + 4);
                *(f32x4*)(out + off + bj * HALF) = v0; *(f32x4*)(out + off + bj * HALF + 4) = v1;
                u32x4 w; w.x = cvt_pk_bf16(v0[0], v0[1]); w.y = cvt_pk_bf16(v0[2], v0[3]); w.z = cvt_pk_bf16(v1[0], v1[1]); w.w = cvt_pk_bf16(v1[2], v1[3]);
                *(u32x4*)(outb + off + bj * HALF) = w;
                s += (v0[0] * v0[0] + v0[1] * v0[1]) + (v0[2] * v0[2] + v0[3] * v0[3]) + (v1[0] * v1[0] + v1[1] * v1[1]) + (v1[2] * v1[2] + v1[3] * v1[3]); }
            if (ssq_out) { s += __shfl_xor(s, 16); s += __shfl_xor(s, 32); if (fq == 0) __hip_atomic_fetch_add(ssq_out + row, s, __ATOMIC_RELAXED, __HIP_MEMORY_SCOPE_AGENT); } }
    }
};
struct EpiSwiglu {
    static constexpr bool PERM = true, AFTER_DRAIN = false;
    bf16_t* O; int ldo; const float* ssq; float inv_d;
    __device__ __forceinline__ void operator()(const f32x4 (&acc)[2][2][4][2], const Unit& u, int wr, int wc, int fr, int fq) const {
        const int row0 = u.pm * BM + wr * 64 + fr, col0 = u.pn * HALF + wc * 32 + 8 * fq;
#pragma unroll
        EPI_LOOP_ROWS { const int row = row0 + ai * HALF + m * 16; const float rs = rsqrtf(ssq[row] * inv_d + RMS_EPS_F);
            float o[8];
#pragma unroll
            for (int n = 0; n < 2; ++n)
#pragma unroll
                for (int j = 0; j < 4; ++j) { const float g = acc[ai][0][m][n][j] * rs, up = acc[ai][1][m][n][j] * rs; o[4 * n + j] = g * sigm(g) * up; }
            *(u32x4*)(O + (size_t)row * ldo + col0) = pack8(o); }
    }
};
template <class Epi, class Sched, bool ALIGN_EPI = false, bool SP2 = false>
__device__ __forceinline__ void gemm_phase(PG8_LAS unsigned char* lds, const Gemm g, const Sched& S, const Epi& E) {
    int tid_ = threadIdx.x; asm volatile("" : "+v"(tid_));
    const int tid = tid_, wid = __builtin_amdgcn_readfirstlane(tid >> 6), lane = tid & 63, wr = wid >> 2, wc = wid & 3, fr = lane & 15, fq = lane >> 4;
    const int K = g.K, nt = K / BK;
    unsigned voffA[2], voffB[2];
#pragma unroll
    for (int i = 0; i < 2; ++i) { int R, C; stage_rc(tid * 16 + i * 8192, R, C); const int Rb = Epi::PERM ? ((R & ~31) + perm32(R & 31)) : R;
        voffA[i] = (unsigned)(R * K + C) * 2u; voffB[i] = (unsigned)(Rb * K + C) * 2u; }
    const size_t kstep = (size_t)(BK * 2);
    const size_t hstep = (size_t)HALF * K * 2;
    const size_t tstep = 2 * hstep;
    const unsigned ldsw = (unsigned)wid * 1024u;
    const int aoff = lds_byte(wr * 64 + fr, fq * 8), boff = lds_byte(wc * 32 + fr, fq * 8);
#define PG8_SA(b, h) (((b) * 2 + (h)) * HTB)
#define PG8_SB(b, h) ((4 + (b) * 2 + (h)) * HTB)
#define PG8_STAGE(bufoff, gbase, voff) do { _Pragma("unroll") for (int _i = 0; _i < 2; ++_i) \
        __builtin_amdgcn_global_load_lds((const unsigned*)((const char*)(gbase) + (voff)[_i]), (PG8_LAS unsigned*)(lds + (bufoff) + ldsw + _i * 8192), 16, 0, 0); } while (0)
#define PG8_LDA(dst, b, h) do { _Pragma("unroll") for (int m = 0; m < 4; ++m) _Pragma("unroll") for (int k = 0; k < 2; ++k) dst[m][k] = *(const PG8_LAS bf16x8*)(lds + PG8_SA(b, h) + aoff + m * 2048 + k * 1024); } while (0)
#define PG8_LDB(dst, b, h) do { _Pragma("unroll") for (int n = 0; n < 2; ++n) _Pragma("unroll") for (int k = 0; k < 2; ++k) dst[n][k] = *(const PG8_LAS bf16x8*)(lds + PG8_SB(b, h) + boff + n * 2048 + k * 1024); } while (0)
#define PG8_MMA(ai, bj, At, Bt) do { __builtin_amdgcn_s_setprio(1); _Pragma("unroll") for (int m = 0; m < 4; ++m) _Pragma("unroll") for (int n = 0; n < 2; ++n) _Pragma("unroll") for (int k = 0; k < 2; ++k) \
        acc[ai][bj][m][n] = __builtin_amdgcn_mfma_f32_16x16x32_bf16(Bt[n][k], At[m][k], acc[ai][bj][m][n], 0, 0, 0); __builtin_amdgcn_s_setprio(0); } while (0)
#define PG8_WAIT_V(n) asm volatile("s_waitcnt vmcnt(" #n ")" ::: "memory")
#define PG8_WAIT_L(n) asm volatile("s_waitcnt lgkmcnt(" #n ")" ::: "memory")
#define PG8_BAR __builtin_amdgcn_s_barrier()
#define PG8_SCHED __builtin_amdgcn_sched_barrier(0)
    Unit cur, nxt; int ui = 0;
    if (!S.next(0, cur)) return;
    f32x4 acc[2][2][4][2];
#pragma unroll
    for (int a = 0; a < 2; ++a)
#pragma unroll
        for (int b = 0; b < 2; ++b)
#pragma unroll
            for (int m = 0; m < 4; ++m)
#pragma unroll
                for (int n = 0; n < 2; ++n) acc[a][b][m][n] = (f32x4){0.f, 0.f, 0.f, 0.f};
    bf16x8 At[4][2], B0[2][2], B1[2][2];
    const char* cA = (const char*)g.A + (size_t)cur.pm * tstep; const char* cB = (const char*)g.Bt + (size_t)cur.pn * tstep;
    S.a_ready(cur);
    if constexpr (SP2) {
        PG8_STAGE(PG8_SB(0, 0), cB, voffB); PG8_STAGE(PG8_SB(0, 1), cB + hstep, voffB); PG8_STAGE(PG8_SA(0, 0), cA, voffA); PG8_STAGE(PG8_SA(0, 1), cA + hstep, voffA);
        if (wr == 1) PG8_BAR;
        PG8_WAIT_V(2); PG8_BAR;
        PG8_STAGE(PG8_SB(1, 0), cB + kstep, voffB); PG8_STAGE(PG8_SA(1, 0), cA + kstep, voffA); PG8_STAGE(PG8_SB(1, 1), cB + hstep + kstep, voffB);
        PG8_WAIT_V(6); PG8_BAR;
    } else {
        PG8_STAGE(PG8_SB(0, 0), cB, voffB); PG8_STAGE(PG8_SA(0, 0), cA, voffA); PG8_STAGE(PG8_SB(0, 1), cB + hstep, voffB); PG8_STAGE(PG8_SA(0, 1), cA + hstep, voffA);
        if (wr == 1) PG8_BAR;
        PG8_WAIT_V(4); PG8_BAR;
        PG8_STAGE(PG8_SB(1, 0), cB + kstep, voffB); PG8_STAGE(PG8_SA(1, 0), cA + kstep, voffA); PG8_STAGE(PG8_SB(1, 1), cB + hstep + kstep, voffB);
        PG8_WAIT_V(6); PG8_BAR;
    }
    for (;;) {
        const bool has_next = S.next(ui + 1, nxt);
        const char* nA = has_next ? (const char*)g.A + (size_t)nxt.pm * tstep : cA; const char* nB = has_next ? (const char*)g.Bt + (size_t)nxt.pn * tstep : cB;
        for (int t = 0; t < nt; t += 2) {
            const bool last = (t == nt - 2);
            const char* a1 = cA + (size_t)(t + 1) * kstep;
            const char* a2 = last ? nA : cA + (size_t)(t + 2) * kstep; const char* b2 = last ? nB : cB + (size_t)(t + 2) * kstep;
            const char* a3 = a2 + kstep; const char* b3 = b2 + kstep;
            if (last && has_next) S.a_ready(nxt);
            if constexpr (SP2) {
            PG8_LDB(B0, 0, 0); PG8_LDB(B1, 0, 1); PG8_SCHED; PG8_LDA(At, 0, 0); PG8_STAGE(PG8_SA(1, 1), a1 + hstep, voffA);
            PG8_WAIT_V(8); PG8_WAIT_L(0); PG8_BAR; PG8_MMA(0, 0, At, B0); PG8_MMA(0, 1, At, B1); PG8_BAR; PG8_SCHED;
            PG8_LDA(At, 0, 1); PG8_STAGE(PG8_SB(0, 0), b2, voffB); PG8_STAGE(PG8_SB(0, 1), b2 + hstep, voffB); PG8_STAGE(PG8_SA(0, 0), a2, voffA);
            PG8_WAIT_V(8); PG8_WAIT_L(0); PG8_BAR; PG8_MMA(1, 0, At, B0); PG8_MMA(1, 1, At, B1); PG8_BAR; PG8_SCHED;
            PG8_LDB(B0, 1, 0); PG8_LDB(B1, 1, 1); PG8_SCHED; PG8_LDA(At, 1, 0); PG8_STAGE(PG8_SA(0, 1), a2 + hstep, voffA);
            PG8_WAIT_V(8); PG8_WAIT_L(0); PG8_BAR; PG8_MMA(0, 0, At, B0); PG8_MMA(0, 1, At, B1); PG8_BAR; PG8_SCHED;
            PG8_LDA(At, 1, 1); PG8_STAGE(PG8_SB(1, 0), b3, voffB); PG8_STAGE(PG8_SB(1, 1), b3 + hstep, voffB); PG8_STAGE(PG8_SA(1, 0), a3, voffA);
            PG8_WAIT_V(8); PG8_WAIT_L(0); PG8_BAR; PG8_MMA(1, 0, At, B0); PG8_MMA(1, 1, At, B1); PG8_BAR; PG8_SCHED;
            } else {
            PG8_LDB(B0, 0, 0); PG8_SCHED; PG8_LDA(At, 0, 0); PG8_STAGE(PG8_SA(1, 1), a1 + hstep, voffA);
            PG8_WAIT_L(8); PG8_BAR; PG8_WAIT_L(0); PG8_MMA(0, 0, At, B0); PG8_BAR; PG8_SCHED;
            PG8_LDB(B1, 0, 1); PG8_STAGE(PG8_SB(0, 0), b2, voffB);
            PG8_BAR; PG8_WAIT_L(0); PG8_MMA(0, 1, At, B1); PG8_BAR;
            PG8_LDA(At, 0, 1); PG8_STAGE(PG8_SA(0, 0), a2, voffA);
            PG8_BAR; PG8_WAIT_L(0); PG8_MMA(1, 0, At, B0); PG8_BAR; PG8_SCHED;
            PG8_STAGE(PG8_SB(0, 1), b2 + hstep, voffB);
            PG8_WAIT_V(6); PG8_BAR; PG8_MMA(1, 1, At, B1); PG8_BAR;
            PG8_LDB(B0, 1, 0); PG8_SCHED; PG8_LDA(At, 1, 0); PG8_STAGE(PG8_SA(0, 1), a2 + hstep, voffA);
            PG8_WAIT_L(8); PG8_BAR; PG8_WAIT_L(0); PG8_MMA(0, 0, At, B0); PG8_BAR; PG8_SCHED;
            PG8_LDB(B1, 1, 1); PG8_STAGE(PG8_SB(1, 0), b3, voffB);
            PG8_BAR; PG8_WAIT_L(0); PG8_MMA(0, 1, At, B1); PG8_BAR;
            PG8_LDA(At, 1, 1); PG8_STAGE(PG8_SA(1, 0), a3, voffA);
            PG8_BAR; PG8_WAIT_L(0); PG8_MMA(1, 0, At, B0); PG8_BAR; PG8_SCHED;
            PG8_STAGE(PG8_SB(1, 1), b3 + hstep, voffB);
            PG8_WAIT_V(6); PG8_BAR; PG8_MMA(1, 1, At, B1); PG8_BAR;
            }
        }
        if constexpr (ALIGN_EPI) { if (wr == 0) PG8_BAR; }
        if constexpr (!Epi::AFTER_DRAIN) { E(acc, cur, wr, wc, fr, fq); S.done(cur); }
        if (!has_next) break;
#pragma unroll
        for (int a = 0; a < 2; ++a)
#pragma unroll
            for (int b = 0; b < 2; ++b)
#pragma unroll
                for (int m = 0; m < 4; ++m)
#pragma unroll
                    for (int n = 0; n < 2; ++n) acc[a][b][m][n] = (f32x4){0.f, 0.f, 0.f, 0.f};
        cur = nxt; cA = nA; cB = nB; ++ui;
        if constexpr (ALIGN_EPI) { if (wr == 1) PG8_BAR; }
    }
    PG8_WAIT_V(0);
    if constexpr (!ALIGN_EPI) { if (wr == 0) PG8_BAR; }
    PG8_BAR;
    if constexpr (Epi::AFTER_DRAIN) { E.fused(acc, cur, wr, wc, fr, fq, lds, wid, lane); S.done(cur); }
#undef PG8_SA
#undef PG8_SB
#undef PG8_STAGE
#undef PG8_LDA
#undef PG8_LDB
#undef PG8_MMA
#undef PG8_WAIT_V
#undef PG8_WAIT_L
#undef PG8_BAR
#undef PG8_SCHED
}
}
constexpr int BATCH = 2, SEQ = 4096, DM = 2048, MTOK = BATCH * SEQ;
constexpr int NQH = 16, NKVH = 4, HD = 64, AW = 1024, KVW = 256, SW = 1024, SG = 64, SP = 64, SH = 16;
constexpr int DFF = 5632, OFF_K = 1024, OFF_V = 1280, OFF_U = 1536, OFF_G = 2560, ZW = 6656;
constexpr float LOG2E = 1.4426950408889634f;
#define LAS __attribute__((address_space(3)))
typedef unsigned short bf16;
typedef unsigned v4u __attribute__((ext_vector_type(4)));
typedef unsigned v2u __attribute__((ext_vector_type(2)));
typedef float f32x4 __attribute__((ext_vector_type(4)));
typedef float f32x16 __attribute__((ext_vector_type(16)));
typedef short bf16x8 __attribute__((ext_vector_type(8)));
#define LDS_WAIT() asm volatile("s_waitcnt lgkmcnt(0)" ::: "memory")
__device__ __forceinline__ unsigned pkbf(float lo, float hi) { unsigned r; asm volatile("v_cvt_pk_bf16_f32 %0, %1, %2" : "=v"(r) : "v"(lo), "v"(hi)); return r; }
__device__ __forceinline__ float bflo(unsigned w) { return __uint_as_float(w << 16); }
__device__ __forceinline__ float bfhi(unsigned w) { return __uint_as_float(w & 0xffff0000u); }
__device__ __forceinline__ void unpk8(const v4u w, float (&f)[8]) { f[0] = bflo(w.x); f[1] = bfhi(w.x); f[2] = bflo(w.y); f[3] = bfhi(w.y); f[4] = bflo(w.z); f[5] = bfhi(w.z); f[6] = bflo(w.w); f[7] = bfhi(w.w); }
__device__ __forceinline__ bf16x8 pk8v(const float (&f)[8]) { v4u w; w.x = pkbf(f[0], f[1]); w.y = pkbf(f[2], f[3]); w.z = pkbf(f[4], f[5]); w.w = pkbf(f[6], f[7]); return __builtin_bit_cast(bf16x8, w); }

namespace att {
constexpr int KP = 72, VP = 264;
constexpr int LDS_K = 0, LDS_V = 256 * KP * 2, LDS_END = LDS_V + 64 * VP * 2;
__device__ __forceinline__ void attn_unit(LAS unsigned char* lds, const bf16* __restrict__ Z, bf16* __restrict__ Y, const float* __restrict__ qg, const float* __restrict__ kg, const float* __restrict__ sinks, int b, int n, int kh) {
    int tid_ = threadIdx.x; asm volatile("" : "+v"(tid_));
    const int tid = tid_, lane = tid & 63, wid = __builtin_amdgcn_readfirstlane(tid >> 6);
    LAS bf16* Ks = (LAS bf16*)(lds + LDS_K); LAS bf16* Vt = (LAS bf16*)(lds + LDS_V);
    {
        const int c = tid & 7; float kgv[8];
#pragma unroll
        for (int i = 0; i < 8; ++i) kgv[i] = kg[8 * c + i];
#pragma unroll
        for (int ps = 0; ps < 4; ++ps) { const int key = ps * 64 + (tid >> 3); const int pos = 128 * n - 128 + key;
            v4u kw = (v4u){0u, 0u, 0u, 0u}, vw = (v4u){0u, 0u, 0u, 0u};
            if (pos >= 0) { const bf16* zr = Z + (size_t)(b * SEQ + pos) * ZW + 64 * kh + 8 * c; kw = *(const v4u*)(zr + OFF_K); vw = *(const v4u*)(zr + OFF_V); }
            float kf[8]; unpk8(kw, kf); float ss = 0.f;
#pragma unroll
            for (int i = 0; i < 8; ++i) ss += kf[i] * kf[i];
            ss += __shfl_xor(ss, 1); ss += __shfl_xor(ss, 2); ss += __shfl_xor(ss, 4);
            const float rs = rsqrtf(ss * (1.0f / 64.0f) + 1e-6f);
#pragma unroll
            for (int i = 0; i < 8; ++i) kf[i] = kf[i] * rs * kgv[i];
            *(LAS bf16x8*)(Ks + key * KP + 8 * c) = pk8v(kf);
            const unsigned vv[4] = {vw.x, vw.y, vw.z, vw.w};
#pragma unroll
            for (int i = 0; i < 4; ++i) { Vt[(8 * c + 2 * i) * VP + key] = (bf16)(vv[i] & 0xffffu); Vt[(8 * c + 2 * i + 1) * VP + key] = (bf16)(vv[i] >> 16); } }
    }
    __syncthreads();
    const int hq = 4 * kh + (wid >> 1), q = lane & 31, hi = lane >> 5;
    const float slope2 = exp2f(-0.5f * (float)(hq + 1)) * LOG2E, sink2 = sinks[hq] * LOG2E;
#pragma unroll 1
    for (int tile = 0; tile < 2; ++tile) {
        const int jq = 2 * (wid & 1) + tile; const size_t tok = (size_t)b * SEQ + 128 * n + 32 * jq + q;
        bf16x8 qf[4];
        {   float qv[4][8]; float ss = 0.f;
#pragma unroll
            for (int d0 = 0; d0 < 4; ++d0) { unpk8(*(const v4u*)(Z + tok * ZW + 64 * hq + 16 * d0 + 8 * hi), qv[d0]);
#pragma unroll
                for (int i = 0; i < 8; ++i) ss += qv[d0][i] * qv[d0][i]; }
            ss += __shfl_xor(ss, 32);
            const float rs = rsqrtf(ss * (1.0f / 64.0f) + 1e-6f) * (0.125f * LOG2E);
#pragma unroll
            for (int d0 = 0; d0 < 4; ++d0) {
#pragma unroll
                for (int i = 0; i < 8; ++i) qv[d0][i] = qv[d0][i] * rs * qg[16 * d0 + 8 * hi + i];
                qf[d0] = pk8v(qv[d0]); }
        }
        f32x16 s[5]; float mx = -INFINITY;
#pragma unroll
        for (int i = 0; i < 5; ++i) { const int kb = jq + i; const bool ok = !(n == 0 && kb < 4);
            if (ok) { f32x16 a = {};
#pragma unroll
                for (int d0 = 0; d0 < 4; ++d0) { const bf16x8 kfr = *(const LAS bf16x8*)(Ks + (32 * kb + q) * KP + 16 * d0 + 8 * hi); a = __builtin_amdgcn_mfma_f32_32x32x16_bf16(kfr, qf[d0], a, 0, 0, 0); }
#pragma unroll
                for (int r = 0; r < 16; ++r) { const int keyrow = (r & 3) + 8 * (r >> 2) + 4 * hi; const int dist = q + 128 - 32 * i - keyrow;
                    const float v = a[r] - slope2 * (float)dist; a[r] = (dist >= 0 && dist < 128) ? v : -INFINITY; mx = fmaxf(mx, a[r]); }
                s[i] = a;
            } else {
#pragma unroll
                for (int r = 0; r < 16; ++r) s[i][r] = -INFINITY; } }
        mx = fmaxf(mx, __shfl_xor(mx, 32)); mx = fmaxf(mx, sink2);
        float lsum = 0.f;
#pragma unroll
        for (int i = 0; i < 5; ++i)
#pragma unroll
            for (int r = 0; r < 16; ++r) { s[i][r] = __builtin_amdgcn_exp2f(s[i][r] - mx); lsum += s[i][r]; }
        lsum += __shfl_xor(lsum, 32);
        const float inv = 1.0f / (lsum + __builtin_amdgcn_exp2f(sink2 - mx));
        f32x16 o[2]; o[0] = f32x16{}; o[1] = f32x16{};
#pragma unroll
        for (int i = 0; i < 5; ++i) { const int kb = jq + i; const bool ok = !(n == 0 && kb < 4);
            if (ok) {
#pragma unroll
                for (int ks = 0; ks < 2; ++ks) { float pv[8];
#pragma unroll
                    for (int j = 0; j < 8; ++j) pv[j] = s[i][8 * ks + j];
                    const bf16x8 pa = pk8v(pv);
#pragma unroll
                    for (int db = 0; db < 2; ++db) { const LAS bf16* vp = Vt + (32 * db + q) * VP + 32 * kb + 16 * ks + 4 * hi;
                        const v2u lo = *(const LAS v2u*)vp, hi2 = *(const LAS v2u*)(vp + 8); const v4u vw = (v4u){lo.x, lo.y, hi2.x, hi2.y};
                        o[db] = __builtin_amdgcn_mfma_f32_32x32x16_bf16(__builtin_bit_cast(bf16x8, vw), pa, o[db], 0, 0, 0); } } } }
        bf16* yr = Y + tok * AW + 64 * hq + 4 * hi;
#pragma unroll
        for (int db = 0; db < 2; ++db)
#pragma unroll
            for (int rq = 0; rq < 4; ++rq) { v2u w; w.x = pkbf(o[db][4 * rq] * inv, o[db][4 * rq + 1] * inv); w.y = pkbf(o[db][4 * rq + 2] * inv, o[db][4 * rq + 3] * inv); *(v2u*)(yr + 32 * db + 8 * rq) = w; }
    }
    __syncthreads();
}
}

namespace ssm {
constexpr int BUP = 20, SXP = 144;
constexpr int WAVE_BYTES = 128 * BUP * 4 + 16 * SXP * 2, CARRY_OFF = 8 * WAVE_BYTES, LDS_END = CARRY_OFF + 8 * 128 * 4;
__device__ __forceinline__ float gelu_tanh(float v) { const float t = 0.7978845608028654f * (v + 0.044715f * v * v * v); const float e = __builtin_amdgcn_exp2f(-2.0f * LOG2E * t); return v * __builtin_amdgcn_rcpf(1.0f + e); }
struct Params { const float *lam_re, *lam_im, *log_dt, *b_re, *b_im, *c_re, *c_im, *dsk; };
__device__ __forceinline__ void zoh(const Params& P, int g, int p, float dt, float& ar, float& ai, float& fr, float& fi) {
    const float lr = P.lam_re[g * SP + p], li = P.lam_im[g * SP + p]; const float mag = expf(lr * dt); float sn, cs; sn = sinf(li * dt); cs = cosf(li * dt);
    ar = mag * cs; ai = mag * sn; const float den = lr * lr + li * li; fr = ((ar - 1.0f) * lr + ai * li) / den; fi = (ai * lr - (ar - 1.0f) * li) / den;
}
__device__ __forceinline__ void ssm_unit(LAS unsigned char* lds, const bf16* __restrict__ Z, bf16* __restrict__ YG, const Params P, int b, int g) {
    int tid_ = threadIdx.x; asm volatile("" : "+v"(tid_));
    const int tid = tid_, lane = tid & 63, wid = __builtin_amdgcn_readfirstlane(tid >> 6), l31 = lane & 31, hi = lane >> 5, l15 = lane & 15, lq = lane >> 4;
    LAS float* bu = (LAS float*)(lds + wid * WAVE_BYTES); LAS bf16* sx = (LAS bf16*)(lds + wid * WAVE_BYTES + 128 * BUP * 4); LAS float* carry = (LAS float*)(lds + CARRY_OFF);
    const float dt = expf(P.log_dt[g]);
    float ar, ai; { float fr_, fi_; zoh(P, g, lane, dt, ar, ai, fr_, fi_); }
    bf16x8 bfrag[4];
#pragma unroll
    for (int h2 = 0; h2 < 2; ++h2) { const int ps = 32 * h2 + l31; float ar2, ai2, fr, fi; zoh(P, g, ps, dt, ar2, ai2, fr, fi);
        float br[8], bi[8], vr[8], vi[8];
#pragma unroll
        for (int i = 0; i < 8; ++i) { br[i] = P.b_re[(g * SP + ps) * SH + 8 * hi + i]; bi[i] = P.b_im[(g * SP + ps) * SH + 8 * hi + i]; vr[i] = fr * br[i] - fi * bi[i]; vi[i] = fr * bi[i] + fi * br[i]; }
        bfrag[h2] = pk8v(vr); bfrag[2 + h2] = pk8v(vi); }
    bf16x8 cfrag[4];
#pragma unroll
    for (int kk = 0; kk < 4; ++kk) { float cv[8];
#pragma unroll
        for (int i = 0; i < 8; ++i) { const int idx = (g * SH + l15) * SP + 32 * (kk & 1) + 8 * lq + i; cv[i] = kk < 2 ? P.c_re[idx] : -P.c_im[idx]; }
        cfrag[kk] = pk8v(cv); }
    float dsk[4];
#pragma unroll
    for (int i = 0; i < 4; ++i) dsk[i] = P.dsk[g * SH + 4 * lq + i];
    const size_t tok0 = (size_t)b * SEQ + 512 * wid;
    const bf16* ubase = Z + tok0 * ZW + OFF_U + SH * g;
    float s_r = 0.f, s_i = 0.f;
#pragma unroll 1
    for (int pass = 0; pass < 2; ++pass) {
        v4u unext = *(const v4u*)(ubase + (size_t)l31 * ZW + 8 * hi);
#pragma unroll 1
        for (int ch = 0; ch < 16; ++ch) {
            const v4u ucur = unext;
            if (ch + 1 < 16) unext = *(const v4u*)(ubase + (size_t)(32 * (ch + 1) + l31) * ZW + 8 * hi);
            f32x16 c[4];
#pragma unroll
            for (int j = 0; j < 4; ++j) c[j] = __builtin_amdgcn_mfma_f32_32x32x16_bf16(__builtin_bit_cast(bf16x8, ucur), bfrag[j], f32x16{}, 0, 0, 0);
#pragma unroll
            for (int half = 0; half < 2; ++half) {
                v2u ue = (v2u){0u, 0u};
                if (pass == 1) ue = *(const v2u*)(ubase + (size_t)(32 * ch + 16 * half + l15) * ZW + 4 * lq);
#pragma unroll
                for (int j = 0; j < 4; ++j)
#pragma unroll
                    for (int qq = 0; qq < 2; ++qq) { const int r0 = 4 * (2 * half + qq); *(LAS f32x4*)(bu + (32 * j + l31) * BUP + 8 * qq + 4 * hi) = (f32x4){c[j][r0], c[j][r0 + 1], c[j][r0 + 2], c[j][r0 + 3]}; }
                LDS_WAIT();
                f32x4 xr[4], xi[4];
#pragma unroll
                for (int k = 0; k < 4; ++k) { xr[k] = *(const LAS f32x4*)(bu + lane * BUP + 4 * k); xi[k] = *(const LAS f32x4*)(bu + (64 + lane) * BUP + 4 * k); }
                LDS_WAIT();
#pragma unroll
                for (int t = 0; t < 16; ++t) { const float nr = ar * s_r - ai * s_i + xr[t >> 2][t & 3], ni = ar * s_i + ai * s_r + xi[t >> 2][t & 3]; s_r = nr; s_i = ni;
                    if (pass == 1) { const unsigned w = pkbf(s_r, s_i); sx[t * SXP + lane] = (bf16)(w & 0xffffu); sx[t * SXP + 64 + lane] = (bf16)(w >> 16); } }
                if (pass == 1) {
                    LDS_WAIT();
                    f32x4 y = {0.f, 0.f, 0.f, 0.f};
#pragma unroll
                    for (int kk = 0; kk < 4; ++kk) { const bf16x8 sf = *(const LAS bf16x8*)(sx + l15 * SXP + 32 * kk + 8 * lq); y = __builtin_amdgcn_mfma_f32_16x16x32_bf16(cfrag[kk], sf, y, 0, 0, 0); }
                    LDS_WAIT();
                    const float u0 = bflo(ue.x), u1 = bfhi(ue.x), u2 = bflo(ue.y), u3 = bfhi(ue.y);
                    v2u w; w.x = pkbf(gelu_tanh(y[0] + dsk[0] * u0), gelu_tanh(y[1] + dsk[1] * u1)); w.y = pkbf(gelu_tanh(y[2] + dsk[2] * u2), gelu_tanh(y[3] + dsk[3] * u3));
                    *(v2u*)(YG + (tok0 + 32 * ch + 16 * half + l15) * SW + SH * g + 4 * lq) = w;
                }
            }
        }
        if (pass == 0) {
            carry[wid * 128 + lane] = s_r; carry[wid * 128 + 64 + lane] = s_i;
            __syncthreads();
            float pr = ar, pi = ai;
#pragma unroll
            for (int k = 0; k < 9; ++k) { const float nr = pr * pr - pi * pi, ni = 2.0f * pr * pi; pr = nr; pi = ni; }
            s_r = 0.f; s_i = 0.f;
            for (int j = 0; j < wid; ++j) { const float er = carry[j * 128 + lane], ei = carry[j * 128 + 64 + lane]; const float nr = pr * s_r - pi * s_i + er, ni = pr * s_i + pi * s_r + ei; s_r = nr; s_i = ni; }
        }
    }
    __syncthreads();
}
}
#define XB_TMO      128
#define XB_XCNT(j)  (256  + 64 * (j))
#define XB_XSUB(j)  (1280 + 64 * (j))
#define XB_XGEN(j)  (2304 + 64 * (j))
#define XB_TOP      3328
#define XB_TOPGEN   3392
#define XCD_BAR_WORDS 3456
#define XB_SPIN_CAP (1u << 18)

__device__ __forceinline__ unsigned xb_ld(unsigned* p)              { return __hip_atomic_load(p, __ATOMIC_RELAXED, __HIP_MEMORY_SCOPE_AGENT); }
__device__ __forceinline__ unsigned xb_add(unsigned* p, unsigned v) { return __hip_atomic_fetch_add(p, v, __ATOMIC_RELAXED, __HIP_MEMORY_SCOPE_AGENT); }
__device__ __forceinline__ unsigned xb_xcc_id() { return (unsigned)__builtin_amdgcn_s_getreg((3 << 11) | 20) & 0xFu; }
#define XB_SPIN(cond, bar) do { unsigned _sp = 0; while (cond) { __builtin_amdgcn_s_sleep(1); \
    if ((++_sp & 255u) == 0u) { if (xb_ld(&(bar)[XB_TMO])) break; if (_sp > XB_SPIN_CAP) { atomicAdd(&(bar)[XB_TMO], 1u); break; } } } } while (0)

struct XcdBarrier {
    unsigned* bar; unsigned x;
    volatile LAS unsigned* st;
};

__device__ __forceinline__ XcdBarrier xcd_barrier_post(unsigned* bar, volatile LAS unsigned* st) {
    XcdBarrier b; b.bar = bar; b.x = xb_xcc_id(); b.st = st;
    if (threadIdx.x == 0) (void)xb_add(&bar[XB_XCNT(b.x)], 1u);
    return b;
}
__device__ __forceinline__ void xcd_barrier_complete(unsigned* bar, unsigned x, unsigned& nloc, unsigned& nx) {
    const unsigned G = gridDim.x * gridDim.y * gridDim.z;
    unsigned sum, cnt, mine, sp = 0u;
    for (;;) {
        sum = 0u; cnt = 0u; mine = 0u;
#pragma unroll
        for (unsigned j = 0; j < 16; ++j) { const unsigned c = xb_ld(&bar[XB_XCNT(j)]); sum += c; cnt += (c > 0u) ? 1u : 0u; mine = (j == x) ? c : mine; }
        if (sum == G) break;
        __builtin_amdgcn_s_sleep(1);
        if ((++sp & 255u) == 0u) { if (xb_ld(&bar[XB_TMO])) break; if (sp > XB_SPIN_CAP) { atomicAdd(&bar[XB_TMO], 1u); break; } }
    }
    nloc = mine > 0u ? mine : 1u; nx = cnt > 0u ? cnt : 1u;
}

__device__ __forceinline__ void xcd_barrier(const XcdBarrier& b) {
    asm volatile("s_waitcnt vmcnt(0)" ::: "memory");
    __syncthreads();
    if (threadIdx.x == 0) {
        unsigned* bar = b.bar;
        __builtin_amdgcn_s_waitcnt(0);
        unsigned nloc = b.st[0], nx = b.st[1];
        if (nloc == 0u) { xcd_barrier_complete(bar, b.x, nloc, nx); b.st[0] = nloc; b.st[1] = nx; }
        const unsigned old = xb_add(&bar[XB_XSUB(b.x)], 1u);
        const unsigned gen = old / nloc;
        if (old + 1u == (gen + 1u) * nloc) {
            __builtin_amdgcn_fence(__ATOMIC_RELEASE, "agent");
            asm volatile("s_waitcnt vmcnt(0)" ::: "memory");
            const unsigned og = xb_add(&bar[XB_TOP], 1u);
            const unsigned tg = og / nx;
            if (og + 1u == (tg + 1u) * nx) xb_add(&bar[XB_TOPGEN], 1u);
            else XB_SPIN(xb_ld(&bar[XB_TOPGEN]) == tg, bar);
            __builtin_amdgcn_fence(__ATOMIC_ACQUIRE, "agent");
            xb_add(&bar[XB_XGEN(b.x)], 1u);
            asm volatile("s_waitcnt vmcnt(0)" ::: "memory");
        } else {
            XB_SPIN(xb_ld(&bar[XB_XGEN(b.x)]) == gen, bar);
            __builtin_amdgcn_fence(__ATOMIC_ACQUIRE, "agent");
            asm volatile("s_waitcnt vmcnt(0)" ::: "memory");
        }
    }
    __syncthreads();
}
#ifndef SKIP_P0
#define SKIP_P0 0
#endif
#ifndef SKIP_SSM
#define SKIP_SSM 0
#endif
#ifndef SKIP_ATT
#define SKIP_ATT 0
#endif
#ifndef REP_P0
#define REP_P0 0
#endif
#ifndef REP_P1
#define REP_P1 0
#endif
#ifndef REP_P2
#define REP_P2 0
#endif
#ifndef REP_P3
#define REP_P3 0
#endif
#ifndef REP_P4
#define REP_P4 0
#endif
#ifndef REP_P5
#define REP_P5 0
#endif
#ifndef REP_P6
#define REP_P6 0
#endif
#ifndef REP_P7
#define REP_P7 0
#endif
#ifndef REP_SYNC
#define REP_SYNC 0
#endif
constexpr int NWAVES = 8, NTHR = NWAVES * 64, NLAYER = 2;
#ifndef MK_N_LAUNCHES
#define MK_N_LAUNCHES 1
#endif
constexpr size_t MiB = 1u << 20;
constexpr size_t WS_CTL = 0, CTL_ZERO_BYTES = 1 * MiB;
constexpr size_t WL_WIN = 0, WL_GLU = WL_WIN + (size_t)ZW * DM * 2, WL_WAB = WL_GLU + (size_t)SW * SW * 2, WL_WSB = WL_WAB + (size_t)DM * AW * 2, WL_WOUT = WL_WSB + (size_t)DM * SW * 2,
                 WL_WFI = WL_WOUT + (size_t)DM * DM * 2, WL_WFO = WL_WFI + (size_t)2 * DFF * DM * 2, WL_SIZE = WL_WFO + (size_t)DM * DFF * 2;
constexpr size_t WS_W = 1 * MiB, WS_XB = WS_W + NLAYER * WL_SIZE, WS_Z = WS_XB + (size_t)MTOK * DM * 2, WS_YA = WS_Z + (size_t)MTOK * ZW * 2, WS_YG = WS_YA + (size_t)MTOK * AW * 2,
                 WS_YS = WS_YG + (size_t)MTOK * SW * 2, WS_T1 = WS_YS + (size_t)MTOK * SW * 2, WS_MG = WS_T1 + (size_t)MTOK * DM * 4, WS_X1 = WS_MG + (size_t)MTOK * DM * 2, WS_END = WS_X1 + (size_t)MTOK * DM * 4;
constexpr size_t WS_ACT = WS_Z;
static_assert((size_t)MTOK * DFF * 2 <= (size_t)MTOK * ZW * 2, "act overlays z");
constexpr int LDS_BYTES = 147456, MISC_OFF = LDS_BYTES - 64;
constexpr size_t CTL_BAR_OFF = 512 * 1024;
static_assert(att::LDS_END <= 131072 && ssm::LDS_END <= 131072, "phase scratch fits the stage region");

struct Args { const float* in[23]; float* out; unsigned char* ws; int ph_lo, ph_hi; };

__device__ __forceinline__ void transpose_item(const float* __restrict__ W, int K, int N, const float* __restrict__ rsc, bf16* __restrict__ WT, bool swi, LAS float* scr, int item, int lane) {
    const int nblk = N / 64, kb = item / nblk, nb = item % nblk, k0 = 64 * kb, n0 = 64 * nb;
    const int c4 = lane & 15, r4 = lane >> 4;
    f32x4 v[16];
#pragma unroll
    for (int i = 0; i < 16; ++i) v[i] = *(const f32x4*)(W + (size_t)(k0 + 4 * i + r4) * N + n0 + 4 * c4);
#pragma unroll
    for (int i = 0; i < 16; ++i) { const int kk = 4 * i + r4; const float sc = rsc ? rsc[k0 + kk] : 1.0f; LAS float* d = scr + kk * 65 + 4 * c4; d[0] = v[i][0] * sc; d[1] = v[i][1] * sc; d[2] = v[i][2] * sc; d[3] = v[i][3] * sc; }
    LDS_WAIT();
    int d0 = n0;
    if (swi) { d0 = (n0 < DFF) ? (256 * (n0 / 128) + (n0 % 128)) : (256 * ((n0 - DFF) / 128) + 128 + ((n0 - DFF) % 128)); }
    const int c = lane & 7;
#pragma unroll
    for (int j = 0; j < 8; ++j) { const int n = (lane >> 3) + 8 * j; const LAS float* s = scr + (8 * c) * 65 + n;
        v4u o; o.x = pkbf(s[0], s[65]); o.y = pkbf(s[2 * 65], s[3 * 65]); o.z = pkbf(s[4 * 65], s[5 * 65]); o.w = pkbf(s[6 * 65], s[7 * 65]);
        *(v4u*)(WT + (size_t)(d0 + n) * K + k0 + 8 * c) = o; }
    LDS_WAIT();
}
__device__ __forceinline__ float wave_sum(float v) {
#pragma unroll
    for (int o = 1; o < 64; o <<= 1) v += __shfl_xor(v, o);
    return v;
}

__global__ void __launch_bounds__(NTHR, 2) fwd_kernel(Args args) {
    extern __shared__ __attribute__((aligned(16))) unsigned char lds_raw[];
    LAS unsigned char* lds = (LAS unsigned char*)lds_raw;
    cg::grid_group grid = cg::this_grid();
    if (threadIdx.x < 16) ((LAS unsigned*)(lds + MISC_OFF))[threadIdx.x] = 0u;
    __syncthreads();
    const XcdBarrier xbar = xcd_barrier_post((unsigned*)(args.ws + WS_CTL + CTL_BAR_OFF), (volatile LAS unsigned*)(lds + MISC_OFF));
    const int tid = threadIdx.x, lane = tid & 63, wave = __builtin_amdgcn_readfirstlane(tid >> 6), G = gridDim.x, bx = blockIdx.x;
    unsigned char* ws = args.ws;
    float* ssq = (float*)(ws + WS_CTL);
    bf16* XB = (bf16*)(ws + WS_XB); bf16* Zb = (bf16*)(ws + WS_Z); bf16* YA = (bf16*)(ws + WS_YA); bf16* YG = (bf16*)(ws + WS_YG); bf16* YS = (bf16*)(ws + WS_YS);
    float* T1 = (float*)(ws + WS_T1); bf16* MG = (bf16*)(ws + WS_MG); float* X1 = (float*)(ws + WS_X1); bf16* ACT = (bf16*)(ws + WS_ACT);
    const float* x_in = args.in[0];
    const int lo = args.ph_lo, hi = args.ph_hi; int ph = 0;
#define IN_PH (lo <= ph && ph < hi)
#define SEAM() do { if (lo <= ph && ph + 1 < hi) { if (ph == 0) grid.sync(); else xcd_barrier(xbar); for (int r_ = 0; r_ < REP_SYNC; ++r_) xcd_barrier(xbar); } ++ph; } while (0)

    for (int rep = 0; rep <= REP_P0; ++rep) if (IN_PH && !SKIP_P0) {
        LAS float* scr = (LAS float*)(lds + wave * (64 * 65 * 4));
        const int gw = bx * NWAVES + wave, NGW = G * NWAVES;
        struct WD { int in_idx, K, N, gain_idx; size_t off; bool swi; };
        const WD wd[7] = {{2, DM, ZW, 1, WL_WIN, false}, {15, SW, SW, -1, WL_GLU, false}, {17, AW, DM, -1, WL_WAB, false}, {18, SW, DM, -1, WL_WSB, false},
                          {19, DM, DM, -1, WL_WOUT, false}, {21, DM, 2 * DFF, 20, WL_WFI, true}, {22, DFF, DM, -1, WL_WFO, false}};
#pragma unroll 1
        for (int l = 0; l < NLAYER; ++l)
#pragma unroll
            for (int w = 0; w < 7; ++w) { const int K = wd[w].K, N = wd[w].N; const int nit = (K / 64) * (N / 64);
                const float* W = args.in[wd[w].in_idx] + (size_t)l * K * N; const float* rsc = wd[w].gain_idx >= 0 ? args.in[wd[w].gain_idx] + (size_t)l * K : nullptr;
                bf16* WT = (bf16*)(ws + WS_W + l * WL_SIZE + wd[w].off);
#pragma unroll 1
                for (int it = gw; it < nit; it += NGW) transpose_item(W, K, N, rsc, WT, wd[w].swi, scr, it, lane); }
#pragma unroll 1
        for (int m = gw; m < MTOK; m += NGW) { const f32x4* xr = (const f32x4*)(x_in + (size_t)m * DM) + lane; f32x4 v[8]; float s = 0.f;
#pragma unroll
            for (int j = 0; j < 8; ++j) { v[j] = xr[64 * j]; s += (v[j][0] * v[j][0] + v[j][1] * v[j][1]) + (v[j][2] * v[j][2] + v[j][3] * v[j][3]); }
            s = wave_sum(s); if (lane == 0) ssq[m] = s;
            v2u* o = (v2u*)(XB + (size_t)m * DM) + lane;
#pragma unroll
            for (int j = 0; j < 8; ++j) { v2u w; w.x = pkbf(v[j][0], v[j][1]); w.y = pkbf(v[j][2], v[j][3]); o[64 * j] = w; } }
        __syncthreads();
    }
    SEAM();
#pragma unroll 1
    for (int l = 0; l < NLAYER; ++l) {
        const unsigned char* wl = ws + WS_W + l * WL_SIZE;
        const bf16* Win = (const bf16*)(wl + WL_WIN); const bf16* Wglu = (const bf16*)(wl + WL_GLU); const bf16* Wab = (const bf16*)(wl + WL_WAB); const bf16* Wsb = (const bf16*)(wl + WL_WSB);
        const bf16* Wout = (const bf16*)(wl + WL_WOUT); const bf16* Wfi = (const bf16*)(wl + WL_WFI); const bf16* Wfo = (const bf16*)(wl + WL_WFO);
        float* ssqA = ssq + (size_t)(2 * l) * MTOK; float* ssqB = ssq + (size_t)(2 * l + 1) * MTOK; float* ssqN = (l + 1 < NLAYER) ? ssq + (size_t)(2 * l + 2) * MTOK : nullptr;
        const float* xres = (l == 0) ? x_in : args.out;
        for (int rep = 0; rep <= REP_P1; ++rep) if (IN_PH) {
            pg8::Gemm g{XB, Win, MTOK, ZW, DM}; pg8::StaticOrder S; S.init(MTOK, ZW, G, bx);
            pg8::EpiWin E{Zb, ZW, ssqA, args.in[3] + (size_t)l * 2 * DM, OFF_G / 256, 1.0f / DM};
            pg8::gemm_phase<pg8::EpiWin, pg8::StaticOrder, true, true>(lds, g, S, E);
        }
        SEAM();
        for (int rep = 0; rep <= REP_P2; ++rep) if (IN_PH) {
            const int nS = G >= 2 ? G / 2 : 1;
            if (!SKIP_SSM && (bx < nS || G < 2)) {
                const ssm::Params P{args.in[7] + (size_t)l * SG * SP, args.in[8] + (size_t)l * SG * SP, args.in[9] + (size_t)l * SG, args.in[10] + (size_t)l * SG * SP * SH, args.in[11] + (size_t)l * SG * SP * SH,
                                    args.in[12] + (size_t)l * SG * SH * SP, args.in[13] + (size_t)l * SG * SH * SP, args.in[14] + (size_t)l * SW};
#pragma unroll 1
                for (int u = bx; u < BATCH * SG; u += nS) ssm::ssm_unit(lds, Zb, YG, P, u / SG, u % SG);
            }
            if (!SKIP_ATT && (bx >= nS || G < 2)) {
                const int a0 = G < 2 ? 0 : bx - nS, na = G < 2 ? 1 : G - nS;
#pragma unroll 1
                for (int u = a0; u < BATCH * 32 * NKVH; u += na) att::attn_unit(lds, Zb, YA, args.in[4] + l * HD, args.in[5] + l * HD, args.in[6] + l * NQH, u / (32 * NKVH), (u / NKVH) % 32, u % NKVH);
            }
        }
        SEAM();
        for (int rep = 0; rep <= REP_P3; ++rep) if (IN_PH) {
            { pg8::Gemm g{YA, Wab, MTOK, DM, AW}; pg8::StaticOrder S; S.init(MTOK, DM, G, bx);
              pg8::EpiGateMerge<true> E{T1, nullptr, DM, Zb + OFF_G, ZW};
              pg8::gemm_phase<pg8::EpiGateMerge<true>, pg8::StaticOrder, true, true>(lds, g, S, E); }
            { pg8::Gemm g{YG, Wglu, MTOK, SW, SW}; pg8::StaticOrder S; S.init(MTOK, SW, G, bx);
              pg8::EpiGlu E{YS, YG, SW, args.in[16] + (size_t)l * SW};
              pg8::gemm_phase<pg8::EpiGlu, pg8::StaticOrder, true, true>(lds, g, S, E); }
        }
        SEAM();
        for (int rep = 0; rep <= REP_P4; ++rep) if (IN_PH) {
            pg8::Gemm g{YS, Wsb, MTOK, DM, SW}; pg8::StaticOrder S; S.init(MTOK, DM, G, bx);
            pg8::EpiGateMerge<false> E{T1, MG, DM, Zb + OFF_G + DM, ZW};
            pg8::gemm_phase<pg8::EpiGateMerge<false>, pg8::StaticOrder, true, true>(lds, g, S, E);
        }
        SEAM();
        for (int rep = 0; rep <= REP_P5; ++rep) if (IN_PH) {
            pg8::Gemm g{MG, Wout, MTOK, DM, DM}; pg8::StaticOrder S; S.init(MTOK, DM, G, bx);
            pg8::EpiResid E{xres, X1, XB, DM, rep ? T1 : ssqB};
            pg8::gemm_phase<pg8::EpiResid, pg8::StaticOrder, true, true>(lds, g, S, E);
        }
        SEAM();
        for (int rep = 0; rep <= REP_P6; ++rep) if (IN_PH) {
            pg8::Gemm g{XB, Wfi, MTOK, 2 * DFF, DM}; pg8::StaticOrder S; S.init(MTOK, 2 * DFF, G, bx);
            pg8::EpiSwiglu E{ACT, DFF, ssqB, 1.0f / DM};
            pg8::gemm_phase<pg8::EpiSwiglu, pg8::StaticOrder, true, true>(lds, g, S, E);
        }
        SEAM();
        for (int rep = 0; rep <= REP_P7; ++rep) if (IN_PH) {
            pg8::Gemm g{ACT, Wfo, MTOK, DM, DFF}; pg8::StaticOrder S; S.init(MTOK, DM, G, bx);
            pg8::EpiResid E{X1, args.out, XB, DM, (rep && ssqN) ? T1 : ssqN};
            pg8::gemm_phase<pg8::EpiResid, pg8::StaticOrder, true, true>(lds, g, S, E);
        }
        SEAM();
    }
#undef IN_PH
#undef SEAM
}
constexpr int N_PHASES = 1 + 7 * NLAYER;

extern "C" void kernel_launch(void* const* d_in, const int* in_sizes, int n_in, void* d_out, int out_size, void* d_ws, size_t ws_size, hipStream_t stream) {
    static int grid = 0;
    if (grid == 0) {
        if (n_in != 23 || in_sizes[0] != MTOK * DM || out_size != MTOK * DM || ws_size < WS_END) { fprintf(stderr, "kernel_launch: unexpected shapes (n_in %d, ws %zu < %zu?)\n", n_in, ws_size, (size_t)WS_END); grid = -1; return; }
        int dev = 0, cus = 0, per_cu = 0;
        hipGetDevice(&dev); hipDeviceGetAttribute(&cus, hipDeviceAttributeMultiprocessorCount, dev);
        hipFuncSetAttribute((const void*)fwd_kernel, hipFuncAttributeMaxDynamicSharedMemorySize, LDS_BYTES);
        hipOccupancyMaxActiveBlocksPerMultiprocessor(&per_cu, (const void*)fwd_kernel, NTHR, LDS_BYTES);
        if (per_cu < 1) { fprintf(stderr, "kernel_launch: occupancy query says %d blocks per CU\n", per_cu); per_cu = 1; }
        (void)hipGetLastError();
        grid = cus;
    }
    if (grid < 0) return;
    hipMemsetAsync((char*)d_ws + WS_CTL, 0, CTL_ZERO_BYTES, stream);
    Args a{};
    for (int i = 0; i < 23; ++i) a.in[i] = (const float*)d_in[i];
    a.out = (float*)d_out; a.ws = (unsigned char*)d_ws;
    const int nl = MK_N_LAUNCHES;
    for (int li = 0; li < nl; ++li) {
        a.ph_lo = (nl == 1) ? 0 : li; a.ph_hi = (nl == 1) ? N_PHASES : li + 1;
        void* kargs[] = {&a};
        hipError_t e = hipLaunchCooperativeKernel((const void*)fwd_kernel, dim3(grid), dim3(NTHR), kargs, LDS_BYTES, stream);
        if (e != hipSuccess) { fprintf(stderr, "kernel_launch: cooperative launch %d failed: %s (grid %d)\n", li, hipGetErrorString(e), grid); break; }
    }
}
```

```cpp
#include <hip/hip_runtime.h>
#include <hip/hip_cooperative_groups.h>
#include <cstdio>
#include <cstdint>
#include <cmath>
namespace cg = cooperative_groups;
namespace pg8 {
#define PG8_LAS __attribute__((address_space(3)))
typedef unsigned short bf16_t;
typedef short bf16x8 __attribute__((ext_vector_type(8)));
typedef float f32x4 __attribute__((ext_vector_type(4)));
typedef unsigned u32x4 __attribute__((ext_vector_type(4)));
constexpr int BM = 256, BK = 64, HALF = 128, HTB = HALF * BK * 2  , STAGE_BYTES = 8 * HTB, NXCD = 8, WGM = 8;

__host__ __device__ __forceinline__ int lds_byte(int r, int c) { const int st = (r >> 4) * 2 + (c >> 5), rr = r & 15, cc = c & 31, ob = rr * 64 + cc * 2; return st * 1024 + (ob ^ (((ob >> 9) & 1) << 5)); }
__host__ __device__ __forceinline__ void stage_rc(int b, int& R, int& C) { const int st = b / 1024, sb = b % 1024, swz = sb ^ (((sb >> 9) & 1) << 5); R = (st >> 1) * 16 + swz / 64; C = (st & 1) * 32 + (swz % 64) / 2; }
__host__ __device__ __forceinline__ int perm32(int rho) { const int n = rho >> 4, i = rho & 15; return 8 * (i >> 2) + 4 * n + (i & 3); }

struct Unit { int pm, pn; };
struct Gemm { const bf16_t* A; const bf16_t* Bt; int M, N, K; };

struct StaticOrder {
    int nM, nN, nwg, G, c;
    __host__ __device__ void init(int M, int N, int G_, int c_) { nM = M / BM; nN = N / BM; nwg = nM * nN; G = G_; c = c_; }
    __host__ __device__ bool next(int i, Unit& u) const {
        const long L = (long)i * G + c; if (L >= nwg) return false;
        int wgid = (int)L; { const int q = nwg / NXCD, r = nwg % NXCD, xcd = wgid % NXCD, off = wgid / NXCD; wgid = (xcd < r ? xcd * (q + 1) : r * (q + 1) + (xcd - r) * q) + off; }
        const int nig = WGM * nN, gid = wgid / nig, fm = gid * WGM, gsz = (nM - fm) < WGM ? (nM - fm) : WGM;
        u.pm = fm + ((wgid % nig) % gsz); u.pn = (wgid % nig) / gsz; return true;
    }
    __device__ __forceinline__ void a_ready(const Unit&) const {}
    __device__ __forceinline__ void done(const Unit&) const {}
};

__device__ __forceinline__ unsigned cvt_pk_bf16(float lo, float hi) { unsigned r; asm volatile("v_cvt_pk_bf16_f32 %0, %1, %2" : "=v"(r) : "v"(lo), "v"(hi)); return r; }
typedef float f32x2 __attribute__((ext_vector_type(2)));
__device__ __forceinline__ f32x2 gelu_pk(f32x2 v) {
    const f32x2 av = __builtin_elementwise_abs(v), d = av * 0.2316418882f + 1.0f;
    f32x2 t; t.x = __builtin_amdgcn_rcpf(d.x); t.y = __builtin_amdgcn_rcpf(d.y);
    f32x2 q = t * 0.5307027145f + (-0.7265760135f); q = q * t + 0.7107068705f; q = q * t + (-0.142248368f); q = q * t + 0.127414796f; q = q * t;
    const f32x2 s = (v * v) * (-0.72134752044f);
    f32x2 e; e.x = __builtin_amdgcn_exp2f(s.x); e.y = __builtin_amdgcn_exp2f(s.y);
    const f32x2 m = v * (q * e), r = v - m;
    f32x2 o; o.x = v.x < 0.f ? m.x : r.x; o.y = v.y < 0.f ? m.y : r.y; return o;
}

constexpr float RMS_EPS_F = 1e-6f;
__device__ __forceinline__ float sigm(float v) { return __builtin_amdgcn_rcpf(1.0f + __builtin_amdgcn_exp2f(-1.4426950408889634f * v)); }
__device__ __forceinline__ float bf_lo(unsigned w) { return __uint_as_float(w << 16); }
__device__ __forceinline__ float bf_hi(unsigned w) { return __uint_as_float(w & 0xffff0000u); }
__device__ __forceinline__ void unpack8(const u32x4 w, float (&f)[8]) { f[0] = bf_lo(w.x); f[1] = bf_hi(w.x); f[2] = bf_lo(w.y); f[3] = bf_hi(w.y); f[4] = bf_lo(w.z); f[5] = bf_hi(w.z); f[6] = bf_lo(w.w); f[7] = bf_hi(w.w); }
__device__ __forceinline__ u32x4 pack8(const float (&f)[8]) { u32x4 w; w.x = cvt_pk_bf16(f[0], f[1]); w.y = cvt_pk_bf16(f[2], f[3]); w.z = cvt_pk_bf16(f[4], f[5]); w.w = cvt_pk_bf16(f[6], f[7]); return w; }
#define EPI_LOOP_ROWS for (int ai = 0; ai < 2; ++ai) _Pragma("unroll") for (int m = 0; m < 4; ++m)

struct EpiWin {
    static constexpr bool PERM = true, AFTER_DRAIN = false;
    bf16_t* Z; int ldz; const float* ssq; const float* gbias; int gate_pn0; float inv_d;
    __device__ __forceinline__ void operator()(const f32x4 (&acc)[2][2][4][2], const Unit& u, int wr, int wc, int fr, int fq) const {
        const int row0 = u.pm * BM + wr * 64 + fr, col0 = u.pn * BM + wc * 32 + 8 * fq;
        const bool gate = u.pn >= gate_pn0;
        f32x4 bv[2][2];
#pragma unroll
        for (int bj = 0; bj < 2; ++bj)
#pragma unroll
            for (int n = 0; n < 2; ++n) bv[bj][n] = gate ? *(const f32x4*)(gbias + (col0 - gate_pn0 * BM) + bj * HALF + 4 * n) : (f32x4){0.f, 0.f, 0.f, 0.f};
#pragma unroll
        EPI_LOOP_ROWS { const int row = row0 + ai * HALF + m * 16; const float rs = rsqrtf(ssq[row] * inv_d + RMS_EPS_F); bf16_t* rowp = Z + (size_t)row * ldz + col0;
#pragma unroll
            for (int bj = 0; bj < 2; ++bj) { f32x4 v0 = acc[ai][bj][m][0] * rs, v1 = acc[ai][bj][m][1] * rs;
                if (gate) { v0 += bv[bj][0]; v1 += bv[bj][1];
#pragma unroll
                    for (int j = 0; j < 4; ++j) { v0[j] = sigm(v0[j]); v1[j] = sigm(v1[j]); } }
                u32x4 w; w.x = cvt_pk_bf16(v0[0], v0[1]); w.y = cvt_pk_bf16(v0[2], v0[3]); w.z = cvt_pk_bf16(v1[0], v1[1]); w.w = cvt_pk_bf16(v1[2], v1[3]);
                *(u32x4*)(rowp + bj * HALF) = w; } }
    }
};
struct EpiGlu {
    static constexpr bool PERM = true, AFTER_DRAIN = false;
    bf16_t* O; const bf16_t* YG; int ld; const float* bias;
    __device__ __forceinline__ void operator()(const f32x4 (&acc)[2][2][4][2], const Unit& u, int wr, int wc, int fr, int fq) const {
        const int row0 = u.pm * BM + wr * 64 + fr, col0 = u.pn * BM + wc * 32 + 8 * fq;
        f32x4 bv[2][2];
#pragma unroll
        for (int bj = 0; bj < 2; ++bj)
#pragma unroll
            for (int n = 0; n < 2; ++n) bv[bj][n] = *(const f32x4*)(bias + col0 + bj * HALF + 4 * n);
#pragma unroll
        EPI_LOOP_ROWS { const size_t off = (size_t)(row0 + ai * HALF + m * 16) * ld + col0;
#pragma unroll
            for (int bj = 0; bj < 2; ++bj) { const f32x4 v0 = acc[ai][bj][m][0] + bv[bj][0], v1 = acc[ai][bj][m][1] + bv[bj][1];
                float y[8]; unpack8(*(const u32x4*)(YG + off + bj * HALF), y); float o[8];
#pragma unroll
                for (int j = 0; j < 4; ++j) { o[j] = y[j] * sigm(v0[j]); o[4 + j] = y[4 + j] * sigm(v1[j]); }
                *(u32x4*)(O + off + bj * HALF) = pack8(o); } }
    }
};
template <bool FIRST> struct EpiGateMerge {
    static constexpr bool PERM = true, AFTER_DRAIN = false;
    float* T; bf16_t* O; int ld; const bf16_t* G; int ldg;
    __device__ __forceinline__ void operator()(const f32x4 (&acc)[2][2][4][2], const Unit& u, int wr, int wc, int fr, int fq) const {
        const int row0 = u.pm * BM + wr * 64 + fr, col0 = u.pn * BM + wc * 32 + 8 * fq;
#pragma unroll
        EPI_LOOP_ROWS { const int row = row0 + ai * HALF + m * 16; const size_t off = (size_t)row * ld + col0; const size_t goff = (size_t)row * ldg + col0;
#pragma unroll
            for (int bj = 0; bj < 2; ++bj) { float g[8]; unpack8(*(const u32x4*)(G + goff + bj * HALF), g);
                f32x4 v0 = acc[ai][bj][m][0], v1 = acc[ai][bj][m][1];
#pragma unroll
                for (int j = 0; j < 4; ++j) { v0[j] *= g[j]; v1[j] *= g[4 + j]; }
                if (FIRST) { *(f32x4*)(T + off + bj * HALF) = v0; *(f32x4*)(T + off + bj * HALF + 4) = v1; }
                else { v0 += *(const f32x4*)(T + off + bj * HALF); v1 += *(const f32x4*)(T + off + bj * HALF + 4);
                    u32x4 w; w.x = cvt_pk_bf16(v0[0], v0[1]); w.y = cvt_pk_bf16(v0[2], v0[3]); w.z = cvt_pk_bf16(v1[0], v1[1]); w.w = cvt_pk_bf16(v1[2], v1[3]);
                    *(u32x4*)(O + off + bj * HALF) = w; } } }
    }
};
struct EpiResid {
    static constexpr bool PERM = true, AFTER_DRAIN = false;
    const float* res; float* out; bf16_t* outb; int ld; float* ssq_out;
    __device__ __forceinline__ void operator()(const f32x4 (&acc)[2][2][4][2], const Unit& u, int wr, int wc, int fr, int fq) const {
        const int row0 = u.pm * BM + wr * 64 + fr, col0 = u.pn * BM + wc * 32 + 8 * fq;
#pragma unroll
        EPI_LOOP_ROWS { const int row = row0 + ai * HALF + m * 16; const size_t off = (size_t)row * ld + col0; float s = 0.f;
#pragma unroll
            for (int bj = 0; bj < 2; ++bj) {
                const f32x4 v0 = acc[ai][bj][m][0] + *(const f32x4*)(res + off + bj * HALF), v1 = acc[ai][bj][m][1] + *(const f32x4*)(res + off + bj * HALF + 4);
                *(f32x4*)(out + off + bj * HALF) = v0; *(f32x4*)(out + off + bj * HALF + 4) = v1;
                u32x4 w; w.x = cvt_pk_bf16(v0[0], v0[1]); w.y = cvt_pk_bf16(v0[2], v0[3]); w.z = cvt_pk_bf16(v1[0], v1[1]); w.w = cvt_pk_bf16(v1[2], v1[3]);
                *(u32x4*)(outb + off + bj * HALF) = w;
                s += (v0[0] * v0[0] + v0[1] * v0[1]) + (v0[2] * v0[2] + v0[3] * v0[3]) + (v1[0] * v1[0] + v1[1] * v1[1]) + (v1[2] * v1[2] + v1[3] * v1[3]); }
            if (ssq_out) { s += __shfl_xor(s, 16); s += __shfl_xor(s, 32); if (fq == 0) __hip_atomic_fetch_add(ssq_out + row, s, __ATOMIC_RELAXED, __HIP_MEMORY_SCOPE_AGENT); } }
    }
};
struct EpiSwiglu {
    static constexpr bool PERM = true, AFTER_DRAIN = false;
    bf16_t* O; int ldo; const float* ssq; float inv_d;
    __device__ __forceinline__ void operator()(const f32x4 (&acc)[2][2][4][2], const Unit& u, int wr, int wc, int fr, int fq) const {
        const int row0 = u.pm * BM + wr * 64 + fr, col0 = u.pn * HALF + wc * 32 + 8 * fq;
#pragma unroll
        EPI_LOOP_ROWS { const int row = row0 + ai * HALF + m * 16; const float rs = rsqrtf(ssq[row] * inv_d + RMS_EPS_F);
            float o[8];
#pragma unroll
            for (int n = 0; n < 2; ++n)
#pragma unroll
                for (int j = 0; j < 4; ++j) { const float g = acc[ai][0][m][n][j] * rs, up = acc[ai][1][m][n][j] * rs; o[4 * n + j] = g * sigm(g) * up; }
            *(u32x4*)(O + (size_t)row * ldo + col0) = pack8(o); }
    }
};
template <class Epi, class Sched, bool ALIGN_EPI = false, bool SP2 = false>
__device__ __forceinline__ void gemm_phase(PG8_LAS unsigned char* lds, const Gemm g, const Sched& S, const Epi& E) {
    int tid_ = threadIdx.x; asm volatile("" : "+v"(tid_));
    const int tid = tid_, wid = __builtin_amdgcn_readfirstlane(tid >> 6), lane = tid & 63, wr = wid >> 2, wc = wid & 3, fr = lane & 15, fq = lane >> 4;
    const int K = g.K, nt = K / BK;
    unsigned voffA[2], voffB[2];
#pragma unroll
    for (int i = 0; i < 2; ++i) { int R, C; stage_rc(tid * 16 + i * 8192, R, C); const int Rb = Epi::PERM ? ((R & ~31) + perm32(R & 31)) : R;
        voffA[i] = (unsigned)(R * K + C) * 2u; voffB[i] = (unsigned)(Rb * K + C) * 2u; }
    const size_t kstep = (size_t)(BK * 2);
    const size_t hstep = (size_t)HALF * K * 2;
    const size_t tstep = 2 * hstep;
    const unsigned ldsw = (unsigned)wid * 1024u;
    const int aoff = lds_byte(wr * 64 + fr, fq * 8), boff = lds_byte(wc * 32 + fr, fq * 8);
#define PG8_SA(b, h) (((b) * 2 + (h)) * HTB)
#define PG8_SB(b, h) ((4 + (b) * 2 + (h)) * HTB)
#define PG8_STAGE(bufoff, gbase, voff) do { _Pragma("unroll") for (int _i = 0; _i < 2; ++_i) \
        __builtin_amdgcn_global_load_lds((const unsigned*)((const char*)(gbase) + (voff)[_i]), (PG8_LAS unsigned*)(lds + (bufoff) + ldsw + _i * 8192), 16, 0, 0); } while (0)
#define PG8_LDA(dst, b, h) do { _Pragma("unroll") for (int m = 0; m < 4; ++m) _Pragma("unroll") for (int k = 0; k < 2; ++k) dst[m][k] = *(const PG8_LAS bf16x8*)(lds + PG8_SA(b, h) + aoff + m * 2048 + k * 1024); } while (0)
#define PG8_LDB(dst, b, h) do { _Pragma("unroll") for (int n = 0; n < 2; ++n) _Pragma("unroll") for (int k = 0; k < 2; ++k) dst[n][k] = *(const PG8_LAS bf16x8*)(lds + PG8_SB(b, h) + boff + n * 2048 + k * 1024); } while (0)
#define PG8_MMA(ai, bj, At, Bt) do { __builtin_amdgcn_s_setprio(1); _Pragma("unroll") for (int m = 0; m < 4; ++m) _Pragma("unroll") for (int n = 0; n < 2; ++n) _Pragma("unroll") for (int k = 0; k < 2; ++k) \
        acc[ai][bj][m][n] = __builtin_amdgcn_mfma_f32_16x16x32_bf16(Bt[n][k], At[m][k], acc[ai][bj][m][n], 0, 0, 0); __builtin_amdgcn_s_setprio(0); } while (0)
#define PG8_WAIT_V(n) asm volatile("s_waitcnt vmcnt(" #n ")" ::: "memory")
#define PG8_WAIT_L(n) asm volatile("s_waitcnt lgkmcnt(" #n ")" ::: "memory")
#define PG8_BAR __builtin_amdgcn_s_barrier()
#define PG8_SCHED __builtin_amdgcn_sched_barrier(0)
    Unit cur, nxt; int ui = 0;
    if (!S.next(0, cur)) return;
    f32x4 acc[2][2][4][2];
#pragma unroll
    for (int a = 0; a < 2; ++a)
#pragma unroll
        for (int b = 0; b < 2; ++b)
#pragma unroll
            for (int m = 0; m < 4; ++m)
#pragma unroll
                for (int n = 0; n < 2; ++n) acc[a][b][m][n] = (f32x4){0.f, 0.f, 0.f, 0.f};
    bf16x8 At[4][2], B0[2][2], B1[2][2];
    const char* cA = (const char*)g.A + (size_t)cur.pm * tstep; const char* cB = (const char*)g.Bt + (size_t)cur.pn * tstep;
    S.a_ready(cur);
    if constexpr (SP2) {
        PG8_STAGE(PG8_SB(0, 0), cB, voffB); PG8_STAGE(PG8_SB(0, 1), cB + hstep, voffB); PG8_STAGE(PG8_SA(0, 0), cA, voffA); PG8_STAGE(PG8_SA(0, 1), cA + hstep, voffA);
        if (wr == 1) PG8_BAR;
        PG8_WAIT_V(2); PG8_BAR;
        PG8_STAGE(PG8_SB(1, 0), cB + kstep, voffB); PG8_STAGE(PG8_SA(1, 0), cA + kstep, voffA); PG8_STAGE(PG8_SB(1, 1), cB + hstep + kstep, voffB);
        PG8_WAIT_V(6); PG8_BAR;
    } else {
        PG8_STAGE(PG8_SB(0, 0), cB, voffB); PG8_STAGE(PG8_SA(0, 0), cA, voffA); PG8_STAGE(PG8_SB(0, 1), cB + hstep, voffB); PG8_STAGE(PG8_SA(0, 1), cA + hstep, voffA);
        if (wr == 1) PG8_BAR;
        PG8_WAIT_V(4); PG8_BAR;
        PG8_STAGE(PG8_SB(1, 0), cB + kstep, voffB); PG8_STAGE(PG8_SA(1, 0), cA + kstep, voffA); PG8_STAGE(PG8_SB(1, 1), cB + hstep + kstep, voffB);
        PG8_WAIT_V(6); PG8_BAR;
    }
    for (;;) {
        const bool has_next = S.next(ui + 1, nxt);
        const char* nA = has_next ? (const char*)g.A + (size_t)nxt.pm * tstep : cA; const char* nB = has_next ? (const char*)g.Bt + (size_t)nxt.pn * tstep : cB;
        for (int t = 0; t < nt; t += 2) {
            const bool last = (t == nt - 2);
            const char* a1 = cA + (size_t)(t + 1) * kstep;
            const char* a2 = last ? nA : cA + (size_t)(t + 2) * kstep; const char* b2 = last ? nB : cB + (size_t)(t + 2) * kstep;
            const char* a3 = a2 + kstep; const char* b3 = b2 + kstep;
            if (last && has_next) S.a_ready(nxt);
            if constexpr (SP2) {
            PG8_LDB(B0, 0, 0); PG8_LDB(B1, 0, 1); PG8_SCHED; PG8_LDA(At, 0, 0); PG8_STAGE(PG8_SA(1, 1), a1 + hstep, voffA);
            PG8_WAIT_V(8); PG8_WAIT_L(0); PG8_BAR; PG8_MMA(0, 0, At, B0); PG8_MMA(0, 1, At, B1); PG8_BAR; PG8_SCHED;
            PG8_LDA(At, 0, 1); PG8_STAGE(PG8_SB(0, 0), b2, voffB); PG8_STAGE(PG8_SB(0, 1), b2 + hstep, voffB); PG8_STAGE(PG8_SA(0, 0), a2, voffA);
            PG8_WAIT_V(8); PG8_WAIT_L(0); PG8_BAR; PG8_MMA(1, 0, At, B0); PG8_MMA(1, 1, At, B1); PG8_BAR; PG8_SCHED;
            PG8_LDB(B0, 1, 0); PG8_LDB(B1, 1, 1); PG8_SCHED; PG8_LDA(At, 1, 0); PG8_STAGE(PG8_SA(0, 1), a2 + hstep, voffA);
            PG8_WAIT_V(8); PG8_WAIT_L(0); PG8_BAR; PG8_MMA(0, 0, At, B0); PG8_MMA(0, 1, At, B1); PG8_BAR; PG8_SCHED;
            PG8_LDA(At, 1, 1); PG8_STAGE(PG8_SB(1, 0), b3, voffB); PG8_STAGE(PG8_SB(1, 1), b3 + hstep, voffB); PG8_STAGE(PG8_SA(1, 0), a3, voffA);
            PG8_WAIT_V(8); PG8_WAIT_L(0); PG8_BAR; PG8_MMA(1, 0, At, B0); PG8_MMA(1, 1, At, B1); PG8_BAR; PG8_SCHED;
            } else {
            PG8_LDB(B0, 0, 0); PG8_SCHED; PG8_LDA(At, 0, 0); PG8_STAGE(PG8_SA(1, 1), a1 + hstep, voffA);
            PG8_WAIT_L(8); PG8_BAR; PG8_WAIT_L(0); PG8_MMA(0, 0, At, B0); PG8_BAR; PG8_SCHED;
            PG8_LDB(B1, 0, 1); PG8_STAGE(PG8_SB(0, 0), b2, voffB);
            PG8_BAR; PG8_WAIT_L(0); PG8_MMA(0, 1, At, B1); PG8_BAR;
            PG8_LDA(At, 0, 1); PG8_STAGE(PG8_SA(0, 0), a2, voffA);
            PG8_BAR; PG8_WAIT_L(0); PG8_MMA(1, 0, At, B0); PG8_BAR; PG8_SCHED;
            PG8_STAGE(PG8_SB(0, 1), b2 + hstep, voffB);
            PG8_WAIT_V(6); PG8_BAR; PG8_MMA(1, 1, At, B1); PG8_BAR;
            PG8_LDB(B0, 1, 0); PG8_SCHED; PG8_LDA(At, 1, 0); PG8_STAGE(PG8_SA(0, 1), a2 + hstep, voffA);
            PG8_WAIT_L(8); PG8_BAR; PG8_WAIT_L(0); PG8_MMA(0, 0, At, B0); PG8_BAR; PG8_SCHED;
            PG8_LDB(B1, 1, 1); PG8_STAGE(PG8_SB(1, 0), b3, voffB);
            PG8_BAR; PG8_WAIT_L(0); PG8_MMA(0, 1, At, B1); PG8_BAR;
            PG8_LDA(At, 1, 1); PG8_STAGE(PG8_SA(1, 0), a3, voffA);
            PG8_BAR; PG8_WAIT_L(0); PG8_MMA(1, 0, At, B0); PG8_BAR; PG8_SCHED;
            PG8_STAGE(PG8_SB(1, 1), b3 + hstep, voffB);
            PG8_WAIT_V(6); PG8_BAR; PG8_MMA(1, 1, At, B1); PG8_BAR;
            }
        }
        if constexpr (ALIGN_EPI) { if (wr == 0) PG8_BAR; }
        if constexpr (!Epi::AFTER_DRAIN) { E(acc, cur, wr, wc, fr, fq); S.done(cur); }
        if (!has_next) break;
#pragma unroll
        for (int a = 0; a < 2; ++a)
#pragma unroll
            for (int b = 0; b < 2; ++b)
#pragma unroll
                for (int m = 0; m < 4; ++m)
#pragma unroll
                    for (int n = 0; n < 2; ++n) acc[a][b][m][n] = (f32x4){0.f, 0.f, 0.f, 0.f};
        cur = nxt; cA = nA; cB = nB; ++ui;
        if constexpr (ALIGN_EPI) { if (wr == 1) PG8_BAR; }
    }
    PG8_WAIT_V(0);
    if constexpr (!ALIGN_EPI) { if (wr == 0) PG8_BAR; }
    PG8_BAR;
    if constexpr (Epi::AFTER_DRAIN) { E.fused(acc, cur, wr, wc, fr, fq, lds, wid, lane); S.done(cur); }
#undef PG8_SA
#undef PG8_SB
#undef PG8_STAGE
#undef PG8_LDA
#undef PG8_LDB
#undef PG8_MMA
#undef PG8_WAIT_V
#undef PG8_WAIT_L
#undef PG8_BAR
#undef PG8_SCHED
}
}
constexpr int BATCH = 2, SEQ = 4096, DM = 2048, MTOK = BATCH * SEQ;
constexpr int NQH = 16, NKVH = 4, HD = 64, AW = 1024, KVW = 256, SW = 1024, SG = 64, SP = 64, SH = 16;
constexpr int DFF = 5632, OFF_K = 1024, OFF_V = 1280, OFF_U = 1536, OFF_G = 2560, ZW = 6656;
constexpr float LOG2E = 1.4426950408889634f;
#define LAS __attribute__((address_space(3)))
typedef unsigned short bf16;
typedef unsigned v4u __attribute__((ext_vector_type(4)));
typedef unsigned v2u __attribute__((ext_vector_type(2)));
typedef float f32x4 __attribute__((ext_vector_type(4)));
typedef float f32x16 __attribute__((ext_vector_type(16)));
typedef short bf16x8 __attribute__((ext_vector_type(8)));
#define LDS_WAIT() asm volatile("s_waitcnt lgkmcnt(0)" ::: "memory")
__device__ __forceinline__ unsigned pkbf(float lo, float hi) { unsigned r; asm volatile("v_cvt_pk_bf16_f32 %0, %1, %2" : "=v"(r) : "v"(lo), "v"(hi)); return r; }
__device__ __forceinline__ float bflo(unsigned w) { return __uint_as_float(w << 16); }
__device__ __forceinline__ float bfhi(unsigned w) { return __uint_as_float(w & 0xffff0000u); }
__device__ __forceinline__ void unpk8(const v4u w, float (&f)[8]) { f[0] = bflo(w.x); f[1] = bfhi(w.x); f[2] = bflo(w.y); f[3] = bfhi(w.y); f[4] = bflo(w.z); f[5] = bfhi(w.z); f[6] = bflo(w.w); f[7] = bfhi(w.w); }
__device__ __forceinline__ bf16x8 pk8v(const float (&f)[8]) { v4u w; w.x = pkbf(f[0], f[1]); w.y = pkbf(f[2], f[3]); w.z = pkbf(f[4], f[5]); w.w = pkbf(f[6], f[7]); return __builtin_bit_cast(bf16x8, w); }

namespace att {
constexpr int KP = 72, VP = 264;
constexpr int LDS_K = 0, LDS_V = 256 * KP * 2, LDS_END = LDS_V + 64 * VP * 2;
__device__ __forceinline__ void attn_unit(LAS unsigned char* lds, const bf16* __restrict__ Z, bf16* __restrict__ Y, const float* __restrict__ qg, const float* __restrict__ kg, const float* __restrict__ sinks, int b, int n, int kh) {
    int tid_ = threadIdx.x; asm volatile("" : "+v"(tid_));
    const int tid = tid_, lane = tid & 63, wid = __builtin_amdgcn_readfirstlane(tid >> 6);
    LAS bf16* Ks = (LAS bf16*)(lds + LDS_K); LAS bf16* Vt = (LAS bf16*)(lds + LDS_V);
    const int hq = 4 * kh + (wid >> 1), q = lane & 31, hi = lane >> 5;
    v4u qraw[2][4];
#pragma unroll
    for (int tile = 0; tile < 2; ++tile)
#pragma unroll
        for (int d0 = 0; d0 < 4; ++d0) qraw[tile][d0] = *(const v4u*)(Z + ((size_t)b * SEQ + 128 * n + 32 * (2 * (wid & 1) + tile) + q) * ZW + 64 * hq + 16 * d0 + 8 * hi);
    {
        const int c = tid & 7; float kgv[8];
#pragma unroll
        for (int i = 0; i < 8; ++i) kgv[i] = kg[8 * c + i];
#pragma unroll
        for (int ps = 0; ps < 4; ++ps) { const int key = ps * 64 + (tid >> 3); const int pos = 128 * n - 128 + key;
            v4u kw = (v4u){0u, 0u, 0u, 0u}, vw = (v4u){0u, 0u, 0u, 0u};
            if (pos >= 0) { const bf16* zr = Z + (size_t)(b * SEQ + pos) * ZW + 64 * kh + 8 * c; kw = *(const v4u*)(zr + OFF_K); vw = *(const v4u*)(zr + OFF_V); }
            float kf[8]; unpk8(kw, kf); float ss = 0.f;
#pragma unroll
            for (int i = 0; i < 8; ++i) ss += kf[i] * kf[i];
            ss += __shfl_xor(ss, 1); ss += __shfl_xor(ss, 2); ss += __shfl_xor(ss, 4);
            const float rs = rsqrtf(ss * (1.0f / 64.0f) + 1e-6f);
#pragma unroll
            for (int i = 0; i < 8; ++i) kf[i] = kf[i] * rs * kgv[i];
            *(LAS bf16x8*)(Ks + key * KP + 8 * c) = pk8v(kf);
            const unsigned vv[4] = {vw.x, vw.y, vw.z, vw.w};
#pragma unroll
            for (int i = 0; i < 4; ++i) { Vt[(8 * c + 2 * i) * VP + key] = (bf16)(vv[i] & 0xffffu); Vt[(8 * c + 2 * i + 1) * VP + key] = (bf16)(vv[i] >> 16); } }
    }
    __syncthreads();
    const float slope2 = exp2f(-0.5f * (float)(hq + 1)) * LOG2E, sink2 = sinks[hq] * LOG2E;
#pragma unroll
    for (int tile = 0; tile < 2; ++tile) {
        const int jq = 2 * (wid & 1) + tile; const size_t tok = (size_t)b * SEQ + 128 * n + 32 * jq + q;
        bf16x8 qf[4];
        {   float qv[4][8]; float ss = 0.f;
#pragma unroll
            for (int d0 = 0; d0 < 4; ++d0) { unpk8(qraw[tile][d0], qv[d0]);
#pragma unroll
                for (int i = 0; i < 8; ++i) ss += qv[d0][i] * qv[d0][i]; }
            ss += __shfl_xor(ss, 32);
            const float rs = rsqrtf(ss * (1.0f / 64.0f) + 1e-6f) * (0.125f * LOG2E);
#pragma unroll
            for (int d0 = 0; d0 < 4; ++d0) {
#pragma unroll
                for (int i = 0; i < 8; ++i) qv[d0][i] = qv[d0][i] * rs * qg[16 * d0 + 8 * hi + i];
                qf[d0] = pk8v(qv[d0]); }
        }
        f32x16 s[5]; float mx = -INFINITY;
#pragma unroll
        for (int i = 0; i < 5; ++i) { const int kb = jq + i; const bool ok = !(n == 0 && kb < 4);
            if (ok) { f32x16 a = {};
#pragma unroll
                for (int d0 = 0; d0 < 4; ++d0) { const bf16x8 kfr = *(const LAS bf16x8*)(Ks + (32 * kb + q) * KP + 16 * d0 + 8 * hi); a = __builtin_amdgcn_mfma_f32_32x32x16_bf16(kfr, qf[d0], a, 0, 0, 0); }
#pragma unroll
                for (int r = 0; r < 16; ++r) { const int keyrow = (r & 3) + 8 * (r >> 2) + 4 * hi; const int dist = q + 128 - 32 * i - keyrow;
                    const float v = a[r] - slope2 * (float)dist; a[r] = (dist >= 0 && dist < 128) ? v : -INFINITY; mx = fmaxf(mx, a[r]); }
                s[i] = a;
            } else {
#pragma unroll
                for (int r = 0; r < 16; ++r) s[i][r] = -INFINITY; } }
        mx = fmaxf(mx, __shfl_xor(mx, 32)); mx = fmaxf(mx, sink2);
        float lsum = 0.f;
#pragma unroll
        for (int i = 0; i < 5; ++i)
#pragma unroll
            for (int r = 0; r < 16; ++r) { s[i][r] = __builtin_amdgcn_exp2f(s[i][r] - mx); lsum += s[i][r]; }
        lsum += __shfl_xor(lsum, 32);
        const float inv = 1.0f / (lsum + __builtin_amdgcn_exp2f(sink2 - mx));
        f32x16 o[2]; o[0] = f32x16{}; o[1] = f32x16{};
#pragma unroll
        for (int i = 0; i < 5; ++i) { const int kb = jq + i; const bool ok = !(n == 0 && kb < 4);
            if (ok) {
#pragma unroll
                for (int ks = 0; ks < 2; ++ks) { float pv[8];
#pragma unroll
                    for (int j = 0; j < 8; ++j) pv[j] = s[i][8 * ks + j];
                    const bf16x8 pa = pk8v(pv);
#pragma unroll
                    for (int db = 0; db < 2; ++db) { const LAS bf16* vp = Vt + (32 * db + q) * VP + 32 * kb + 16 * ks + 4 * hi;
                        const v2u lo = *(const LAS v2u*)vp, hi2 = *(const LAS v2u*)(vp + 8); const v4u vw = (v4u){lo.x, lo.y, hi2.x, hi2.y};
                        o[db] = __builtin_amdgcn_mfma_f32_32x32x16_bf16(__builtin_bit_cast(bf16x8, vw), pa, o[db], 0, 0, 0); } } } }
        bf16* yr = Y + tok * AW + 64 * hq + 4 * hi;
#pragma unroll
        for (int db = 0; db < 2; ++db)
#pragma unroll
            for (int rq = 0; rq < 4; ++rq) { v2u w; w.x = pkbf(o[db][4 * rq] * inv, o[db][4 * rq + 1] * inv); w.y = pkbf(o[db][4 * rq + 2] * inv, o[db][4 * rq + 3] * inv); *(v2u*)(yr + 32 * db + 8 * rq) = w; }
    }
    __syncthreads();
}
}

namespace ssm {
constexpr int BUP = 20, SXP = 144;
constexpr int WAVE_BYTES = 128 * BUP * 4 + 16 * SXP * 2, CARRY_OFF = 8 * WAVE_BYTES, LDS_END = CARRY_OFF + 8 * 128 * 4;
__device__ __forceinline__ float gelu_tanh(float v) { const float t = 0.7978845608028654f * (v + 0.044715f * v * v * v); const float e = __builtin_amdgcn_exp2f(-2.0f * LOG2E * t); return v * __builtin_amdgcn_rcpf(1.0f + e); }
struct Params { const float *lam_re, *lam_im, *log_dt, *b_re, *b_im, *c_re, *c_im, *dsk; };
__device__ __forceinline__ void zoh(const Params& P, int g, int p, float dt, float& ar, float& ai, float& fr, float& fi) {
    const float lr = P.lam_re[g * SP + p], li = P.lam_im[g * SP + p]; const float mag = expf(lr * dt); float sn, cs; sn = sinf(li * dt); cs = cosf(li * dt);
    ar = mag * cs; ai = mag * sn; const float den = lr * lr + li * li; fr = ((ar - 1.0f) * lr + ai * li) / den; fi = (ai * lr - (ar - 1.0f) * li) / den;
}
__device__ __forceinline__ void ssm_unit(LAS unsigned char* lds, const bf16* __restrict__ Z, bf16* __restrict__ YG, const Params P, int b, int g) {
    int tid_ = threadIdx.x; asm volatile("" : "+v"(tid_));
    const int tid = tid_, lane = tid & 63, wid = __builtin_amdgcn_readfirstlane(tid >> 6), l31 = lane & 31, hi = lane >> 5, l15 = lane & 15, lq = lane >> 4;
    LAS float* bu = (LAS float*)(lds + wid * WAVE_BYTES); LAS bf16* sx = (LAS bf16*)(lds + wid * WAVE_BYTES + 128 * BUP * 4); LAS float* carry = (LAS float*)(lds + CARRY_OFF);
    const float dt = expf(P.log_dt[g]);
    float ar, ai; { float fr_, fi_; zoh(P, g, lane, dt, ar, ai, fr_, fi_); }
    bf16x8 bfrag[4];
#pragma unroll
    for (int h2 = 0; h2 < 2; ++h2) { const int ps = 32 * h2 + l31; float ar2, ai2, fr, fi; zoh(P, g, ps, dt, ar2, ai2, fr, fi);
        float br[8], bi[8], vr[8], vi[8];
#pragma unroll
        for (int i = 0; i < 8; ++i) { br[i] = P.b_re[(g * SP + ps) * SH + 8 * hi + i]; bi[i] = P.b_im[(g * SP + ps) * SH + 8 * hi + i]; vr[i] = fr * br[i] - fi * bi[i]; vi[i] = fr * bi[i] + fi * br[i]; }
        bfrag[h2] = pk8v(vr); bfrag[2 + h2] = pk8v(vi); }
    bf16x8 cfrag[4];
#pragma unroll
    for (int kk = 0; kk < 4; ++kk) { float cv[8];
#pragma unroll
        for (int i = 0; i < 8; ++i) { const int idx = (g * SH + l15) * SP + 32 * (kk & 1) + 8 * lq + i; cv[i] = kk < 2 ? P.c_re[idx] : -P.c_im[idx]; }
        cfrag[kk] = pk8v(cv); }
    float dsk[4];
#pragma unroll
    for (int i = 0; i < 4; ++i) dsk[i] = P.dsk[g * SH + 4 * lq + i];
    const size_t tok0 = (size_t)b * SEQ + 512 * wid;
    const bf16* ubase = Z + tok0 * ZW + OFF_U + SH * g;
    float s_r = 0.f, s_i = 0.f;
#pragma unroll 1
    for (int pass = 0; pass < 2; ++pass) {
        v4u ring[4];
#pragma unroll
        for (int i = 0; i < 4; ++i) ring[i] = *(const v4u*)(ubase + (size_t)(32 * i + l31) * ZW + 8 * hi);
#pragma unroll 1
        for (int cg4 = 0; cg4 < 4; ++cg4)
#pragma unroll
        for (int ci = 0; ci < 4; ++ci) { const int ch = 4 * cg4 + ci;
            const v4u ucur = ring[ci];
            if (cg4 < 3) ring[ci] = *(const v4u*)(ubase + (size_t)(32 * (ch + 4) + l31) * ZW + 8 * hi);
            f32x16 c[4];
#pragma unroll
            for (int j = 0; j < 4; ++j) c[j] = __builtin_amdgcn_mfma_f32_32x32x16_bf16(__builtin_bit_cast(bf16x8, ucur), bfrag[j], f32x16{}, 0, 0, 0);
#pragma unroll
            for (int half = 0; half < 2; ++half) {
                v2u ue = (v2u){0u, 0u};
                if (pass == 1) { const int src = 16 * half + l15 + 32 * (lq >> 1);
                    const unsigned d0 = __shfl(ucur.x, src), d1 = __shfl(ucur.y, src), d2 = __shfl(ucur.z, src), d3 = __shfl(ucur.w, src);
                    ue.x = (lq & 1) ? d2 : d0; ue.y = (lq & 1) ? d3 : d1; }
#pragma unroll
                for (int j = 0; j < 4; ++j)
#pragma unroll
                    for (int qq = 0; qq < 2; ++qq) { const int r0 = 4 * (2 * half + qq); *(LAS f32x4*)(bu + (32 * j + l31) * BUP + 8 * qq + 4 * hi) = (f32x4){c[j][r0], c[j][r0 + 1], c[j][r0 + 2], c[j][r0 + 3]}; }
                LDS_WAIT();
                f32x4 xr[4], xi[4];
#pragma unroll
                for (int k = 0; k < 4; ++k) { xr[k] = *(const LAS f32x4*)(bu + lane * BUP + 4 * k); xi[k] = *(const LAS f32x4*)(bu + (64 + lane) * BUP + 4 * k); }
                LDS_WAIT();
#pragma unroll
                for (int t = 0; t < 16; ++t) { const float nr = ar * s_r - ai * s_i + xr[t >> 2][t & 3], ni = ar * s_i + ai * s_r + xi[t >> 2][t & 3]; s_r = nr; s_i = ni;
                    if (pass == 1) { const unsigned w = pkbf(s_r, s_i); sx[t * SXP + lane] = (bf16)(w & 0xffffu); sx[t * SXP + 64 + lane] = (bf16)(w >> 16); } }
                if (pass == 1) {
                    LDS_WAIT();
                    f32x4 y = {0.f, 0.f, 0.f, 0.f};
#pragma unroll
                    for (int kk = 0; kk < 4; ++kk) { const bf16x8 sf = *(const LAS bf16x8*)(sx + l15 * SXP + 32 * kk + 8 * lq); y = __builtin_amdgcn_mfma_f32_16x16x32_bf16(cfrag[kk], sf, y, 0, 0, 0); }
                    LDS_WAIT();
                    const float u0 = bflo(ue.x), u1 = bfhi(ue.x), u2 = bflo(ue.y), u3 = bfhi(ue.y);
                    v2u w; w.x = pkbf(gelu_tanh(y[0] + dsk[0] * u0), gelu_tanh(y[1] + dsk[1] * u1)); w.y = pkbf(gelu_tanh(y[2] + dsk[2] * u2), gelu_tanh(y[3] + dsk[3] * u3));
                    *(v2u*)(YG + (tok0 + 32 * ch + 16 * half + l15) * SW + SH * g + 4 * lq) = w;
                }
            }
        }
        if (pass == 0) {
            carry[wid * 128 + lane] = s_r; carry[wid * 128 + 64 + lane] = s_i;
            __syncthreads();
            float pr = ar, pi = ai;
#pragma unroll
            for (int k = 0; k < 9; ++k) { const float nr = pr * pr - pi * pi, ni = 2.0f * pr * pi; pr = nr; pi = ni; }
            s_r = 0.f; s_i = 0.f;
            for (int j = 0; j < wid; ++j) { const float er = carry[j * 128 + lane], ei = carry[j * 128 + 64 + lane]; const float nr = pr * s_r - pi * s_i + er, ni = pr * s_i + pi * s_r + ei; s_r = nr; s_i = ni; }
        }
    }
    __syncthreads();
}
}
#define XB_TMO      128
#define XB_XCNT(j)  (256  + 64 * (j))
#define XB_XSUB(j)  (1280 + 64 * (j))
#define XB_XGEN(j)  (2304 + 64 * (j))
#define XB_TOP      3328
#define XB_TOPGEN   3392
#define XCD_BAR_WORDS 3456
#define XB_SPIN_CAP (1u << 18)

__device__ __forceinline__ unsigned xb_ld(unsigned* p)              { return __hip_atomic_load(p, __ATOMIC_RELAXED, __HIP_MEMORY_SCOPE_AGENT); }
__device__ __forceinline__ unsigned xb_add(unsigned* p, unsigned v) { return __hip_atomic_fetch_add(p, v, __ATOMIC_RELAXED, __HIP_MEMORY_SCOPE_AGENT); }
__device__ __forceinline__ unsigned xb_xcc_id() { return (unsigned)__builtin_amdgcn_s_getreg((3 << 11) | 20) & 0xFu; }
#define XB_SPIN(cond, bar) do { unsigned _sp = 0; while (cond) { __builtin_amdgcn_s_sleep(1); \
    if ((++_sp & 255u) == 0u) { if (xb_ld(&(bar)[XB_TMO])) break; if (_sp > XB_SPIN_CAP) { atomicAdd(&(bar)[XB_TMO], 1u); break; } } } } while (0)

struct XcdBarrier {
    unsigned* bar; unsigned x;
    volatile LAS unsigned* st;
};

__device__ __forceinline__ XcdBarrier xcd_barrier_post(unsigned* bar, volatile LAS unsigned* st) {
    XcdBarrier b; b.bar = bar; b.x = xb_xcc_id(); b.st = st;
    if (threadIdx.x == 0) (void)xb_add(&bar[XB_XCNT(b.x)], 1u);
    return b;
}
__device__ __forceinline__ void xcd_barrier_complete(unsigned* bar, unsigned x, unsigned& nloc, unsigned& nx) {
    const unsigned G = gridDim.x * gridDim.y * gridDim.z;
    unsigned sum, cnt, mine, sp = 0u;
    for (;;) {
        sum = 0u; cnt = 0u; mine = 0u;
#pragma unroll
        for (unsigned j = 0; j < 16; ++j) { const unsigned c = xb_ld(&bar[XB_XCNT(j)]); sum += c; cnt += (c > 0u) ? 1u : 0u; mine = (j == x) ? c : mine; }
        if (sum == G) break;
        __builtin_amdgcn_s_sleep(1);
        if ((++sp & 255u) == 0u) { if (xb_ld(&bar[XB_TMO])) break; if (sp > XB_SPIN_CAP) { atomicAdd(&bar[XB_TMO], 1u); break; } }
    }
    nloc = mine > 0u ? mine : 1u; nx = cnt > 0u ? cnt : 1u;
}

__device__ __forceinline__ void xcd_barrier(const XcdBarrier& b) {
    asm volatile("s_waitcnt vmcnt(0)" ::: "memory");
    __syncthreads();
    if (threadIdx.x == 0) {
        unsigned* bar = b.bar;
        __builtin_amdgcn_s_waitcnt(0);
        unsigned nloc = b.st[0], nx = b.st[1];
        if (nloc == 0u) { xcd_barrier_complete(bar, b.x, nloc, nx); b.st[0] = nloc; b.st[1] = nx; }
        const unsigned old = xb_add(&bar[XB_XSUB(b.x)], 1u);
        const unsigned gen = old / nloc;
        if (old + 1u == (gen + 1u) * nloc) {
            __builtin_amdgcn_fence(__ATOMIC_RELEASE, "agent");
            asm volatile("s_waitcnt vmcnt(0)" ::: "memory");
            const unsigned og = xb_add(&bar[XB_TOP], 1u);
            const unsigned tg = og / nx;
            if (og + 1u == (tg + 1u) * nx) xb_add(&bar[XB_TOPGEN], 1u);
            else XB_SPIN(xb_ld(&bar[XB_TOPGEN]) == tg, bar);
            __builtin_amdgcn_fence(__ATOMIC_ACQUIRE, "agent");
            xb_add(&bar[XB_XGEN(b.x)], 1u);
            asm volatile("s_waitcnt vmcnt(0)" ::: "memory");
        } else {
            XB_SPIN(xb_ld(&bar[XB_XGEN(b.x)]) == gen, bar);
            __builtin_amdgcn_fence(__ATOMIC_ACQUIRE, "agent");
            asm volatile("s_waitcnt vmcnt(0)" ::: "memory");
        }
    }
    __syncthreads();
}
#ifndef SKIP_P0
#define SKIP_P0 0
#endif
#ifndef SKIP_SSM
#define SKIP_SSM 0
#endif
#ifndef SKIP_ATT
#define SKIP_ATT 0
#endif
#ifndef REP_P0
#define REP_P0 0
#endif
#ifndef REP_P1
#define REP_P1 0
#endif
#ifndef REP_P2
#define REP_P2 0
#endif
#ifndef REP_P3
#define REP_P3 0
#endif
#ifndef REP_P4
#define REP_P4 0
#endif
#ifndef REP_P5
#define REP_P5 0
#endif
#ifndef REP_P6
#define REP_P6 0
#endif
#ifndef REP_P7
#define REP_P7 0
#endif
#ifndef REP_SSM
#define REP_SSM 0
#endif
#ifndef REP_ATT
#define REP_ATT 0
#endif
#ifndef REP_SYNC
#define REP_SYNC 0
#endif
constexpr int NWAVES = 8, NTHR = NWAVES * 64, NLAYER = 2;
#ifndef MK_N_LAUNCHES
#define MK_N_LAUNCHES 1
#endif
constexpr size_t MiB = 1u << 20;
constexpr size_t WS_CTL = 0, CTL_ZERO_BYTES = 1 * MiB;
constexpr size_t WL_WIN = 0, WL_GLU = WL_WIN + (size_t)ZW * DM * 2, WL_WAB = WL_GLU + (size_t)SW * SW * 2, WL_WSB = WL_WAB + (size_t)DM * AW * 2, WL_WOUT = WL_WSB + (size_t)DM * SW * 2,
                 WL_WFI = WL_WOUT + (size_t)DM * DM * 2, WL_WFO = WL_WFI + (size_t)2 * DFF * DM * 2, WL_SIZE = WL_WFO + (size_t)DM * DFF * 2;
constexpr size_t WS_W = 1 * MiB, WS_XB = WS_W + NLAYER * WL_SIZE, WS_Z = WS_XB + (size_t)MTOK * DM * 2, WS_YA = WS_Z + (size_t)MTOK * ZW * 2, WS_YG = WS_YA + (size_t)MTOK * AW * 2,
                 WS_YS = WS_YG + (size_t)MTOK * SW * 2, WS_T1 = WS_YS + (size_t)MTOK * SW * 2, WS_MG = WS_T1 + (size_t)MTOK * DM * 4, WS_X1 = WS_MG + (size_t)MTOK * DM * 2, WS_END = WS_X1 + (size_t)MTOK * DM * 4;
constexpr size_t WS_ACT = WS_Z;
static_assert((size_t)MTOK * DFF * 2 <= (size_t)MTOK * ZW * 2, "act overlays z");
constexpr int LDS_BYTES = 147456, MISC_OFF = LDS_BYTES - 64;
constexpr size_t CTL_BAR_OFF = 512 * 1024;
static_assert(att::LDS_END <= 131072 && ssm::LDS_END <= 131072, "phase scratch fits the stage region");

struct Args { const float* in[23]; float* out; unsigned char* ws; int ph_lo, ph_hi; };

__device__ __forceinline__ void transpose_item(const float* __restrict__ W, int K, int N, const float* __restrict__ rsc, bf16* __restrict__ WT, bool swi, LAS float* scr, int item, int lane) {
    const int nblk = N / 64, kb = item / nblk, nb = item % nblk, k0 = 64 * kb, n0 = 64 * nb;
    const int c4 = lane & 15, r4 = lane >> 4;
    f32x4 v[16];
#pragma unroll
    for (int i = 0; i < 16; ++i) v[i] = *(const f32x4*)(W + (size_t)(k0 + 4 * i + r4) * N + n0 + 4 * c4);
#pragma unroll
    for (int i = 0; i < 16; ++i) { const int kk = 4 * i + r4; const float sc = rsc ? rsc[k0 + kk] : 1.0f; LAS float* d = scr + kk * 65 + 4 * c4; d[0] = v[i][0] * sc; d[1] = v[i][1] * sc; d[2] = v[i][2] * sc; d[3] = v[i][3] * sc; }
    LDS_WAIT();
    int d0 = n0;
    if (swi) { d0 = (n0 < DFF) ? (256 * (n0 / 128) + (n0 % 128)) : (256 * ((n0 - DFF) / 128) + 128 + ((n0 - DFF) % 128)); }
    const int c = lane & 7;
#pragma unroll
    for (int j = 0; j < 8; ++j) { const int n = (lane >> 3) + 8 * j; const LAS float* s = scr + (8 * c) * 65 + n;
        v4u o; o.x = pkbf(s[0], s[65]); o.y = pkbf(s[2 * 65], s[3 * 65]); o.z = pkbf(s[4 * 65], s[5 * 65]); o.w = pkbf(s[6 * 65], s[7 * 65]);
        *(v4u*)(WT + (size_t)(d0 + n) * K + k0 + 8 * c) = o; }
    LDS_WAIT();
}
__device__ __forceinline__ float wave_sum(float v) {
#pragma unroll
    for (int o = 1; o < 64; o <<= 1) v += __shfl_xor(v, o);
    return v;
}

__global__ void __launch_bounds__(NTHR, 2) fwd_kernel(Args args) {
    extern __shared__ __attribute__((aligned(16))) unsigned char lds_raw[];
    LAS unsigned char* lds = (LAS unsigned char*)lds_raw;
    cg::grid_group grid = cg::this_grid();
    if (threadIdx.x < 16) ((LAS unsigned*)(lds + MISC_OFF))[threadIdx.x] = 0u;
    __syncthreads();
    const XcdBarrier xbar = xcd_barrier_post((unsigned*)(args.ws + WS_CTL + CTL_BAR_OFF), (volatile LAS unsigned*)(lds + MISC_OFF));
    const int tid = threadIdx.x, lane = tid & 63, wave = __builtin_amdgcn_readfirstlane(tid >> 6), G = gridDim.x, bx = blockIdx.x;
    unsigned char* ws = args.ws;
    float* ssq = (float*)(ws + WS_CTL);
    bf16* XB = (bf16*)(ws + WS_XB); bf16* Zb = (bf16*)(ws + WS_Z); bf16* YA = (bf16*)(ws + WS_YA); bf16* YG = (bf16*)(ws + WS_YG); bf16* YS = (bf16*)(ws + WS_YS);
    float* T1 = (float*)(ws + WS_T1); bf16* MG = (bf16*)(ws + WS_MG); float* X1 = (float*)(ws + WS_X1); bf16* ACT = (bf16*)(ws + WS_ACT);
    const float* x_in = args.in[0];
    const int lo = args.ph_lo, hi = args.ph_hi; int ph = 0;
#define IN_PH (lo <= ph && ph < hi)
#define SEAM() do { if (lo <= ph && ph + 1 < hi) { xcd_barrier(xbar); for (int r_ = 0; r_ < REP_SYNC; ++r_) xcd_barrier(xbar); } ++ph; } while (0)
    if (hi < 0) grid.sync();

    for (int rep = 0; rep <= REP_P0; ++rep) if (IN_PH && !SKIP_P0) {
        LAS float* scr = (LAS float*)(lds + wave * (64 * 65 * 4));
        const int gw = bx * NWAVES + wave, NGW = G * NWAVES;
        struct WD { int in_idx, K, N, gain_idx; size_t off; bool swi; };
        const WD wd[7] = {{2, DM, ZW, 1, WL_WIN, false}, {15, SW, SW, -1, WL_GLU, false}, {17, AW, DM, -1, WL_WAB, false}, {18, SW, DM, -1, WL_WSB, false},
                          {19, DM, DM, -1, WL_WOUT, false}, {21, DM, 2 * DFF, 20, WL_WFI, true}, {22, DFF, DM, -1, WL_WFO, false}};
#pragma unroll 1
        for (int l = 0; l < NLAYER; ++l)
#pragma unroll
            for (int w = 0; w < 7; ++w) { const int K = wd[w].K, N = wd[w].N; const int nit = (K / 64) * (N / 64);
                const float* W = args.in[wd[w].in_idx] + (size_t)l * K * N; const float* rsc = wd[w].gain_idx >= 0 ? args.in[wd[w].gain_idx] + (size_t)l * K : nullptr;
                bf16* WT = (bf16*)(ws + WS_W + l * WL_SIZE + wd[w].off);
#pragma unroll 1
                for (int it = gw; it < nit; it += NGW) transpose_item(W, K, N, rsc, WT, wd[w].swi, scr, it, lane); }
#pragma unroll 1
        for (int m = gw; m < MTOK; m += NGW) { const f32x4* xr = (const f32x4*)(x_in + (size_t)m * DM) + lane; f32x4 v[8]; float s = 0.f;
#pragma unroll
            for (int j = 0; j < 8; ++j) { v[j] = xr[64 * j]; s += (v[j][0] * v[j][0] + v[j][1] * v[j][1]) + (v[j][2] * v[j][2] + v[j][3] * v[j][3]); }
            s = wave_sum(s); if (lane == 0) ssq[m] = s;
            v2u* o = (v2u*)(XB + (size_t)m * DM) + lane;
#pragma unroll
            for (int j = 0; j < 8; ++j) { v2u w; w.x = pkbf(v[j][0], v[j][1]); w.y = pkbf(v[j][2], v[j][3]); o[64 * j] = w; } }
        __syncthreads();
    }
    SEAM();
#pragma unroll 1
    for (int l = 0; l < NLAYER; ++l) {
        const unsigned char* wl = ws + WS_W + l * WL_SIZE;
        const bf16* Win = (const bf16*)(wl + WL_WIN); const bf16* Wglu = (const bf16*)(wl + WL_GLU); const bf16* Wab = (const bf16*)(wl + WL_WAB); const bf16* Wsb = (const bf16*)(wl + WL_WSB);
        const bf16* Wout = (const bf16*)(wl + WL_WOUT); const bf16* Wfi = (const bf16*)(wl + WL_WFI); const bf16* Wfo = (const bf16*)(wl + WL_WFO);
        float* ssqA = ssq + (size_t)(2 * l) * MTOK; float* ssqB = ssq + (size_t)(2 * l + 1) * MTOK; float* ssqN = (l + 1 < NLAYER) ? ssq + (size_t)(2 * l + 2) * MTOK : nullptr;
        const float* xres = (l == 0) ? x_in : args.out;
        for (int rep = 0; rep <= REP_P1; ++rep) if (IN_PH) {
            pg8::Gemm g{XB, Win, MTOK, ZW, DM}; pg8::StaticOrder S; S.init(MTOK, ZW, G, bx);
            pg8::EpiWin E{Zb, ZW, ssqA, args.in[3] + (size_t)l * 2 * DM, OFF_G / 256, 1.0f / DM};
            pg8::gemm_phase<pg8::EpiWin, pg8::StaticOrder, true, true>(lds, g, S, E);
        }
        SEAM();
        for (int rep = 0; rep <= REP_P2; ++rep) if (IN_PH) {
            const int nS = G >= 2 ? G / 2 : 1;
            if (!SKIP_SSM && (bx < nS || G < 2)) {
                const ssm::Params P{args.in[7] + (size_t)l * SG * SP, args.in[8] + (size_t)l * SG * SP, args.in[9] + (size_t)l * SG, args.in[10] + (size_t)l * SG * SP * SH, args.in[11] + (size_t)l * SG * SP * SH,
                                    args.in[12] + (size_t)l * SG * SH * SP, args.in[13] + (size_t)l * SG * SH * SP, args.in[14] + (size_t)l * SW};
#pragma unroll 1
                for (int r2 = 0; r2 <= REP_SSM; ++r2) for (int u = bx; u < BATCH * SG; u += nS) ssm::ssm_unit(lds, Zb, YG, P, u / SG, u % SG);
            }
            if (!SKIP_ATT && (bx >= nS || G < 2)) {
                const int a0 = G < 2 ? 0 : bx - nS, na = G < 2 ? 1 : G - nS;
#pragma unroll 1
                for (int r2 = 0; r2 <= REP_ATT; ++r2) for (int u = a0; u < BATCH * 32 * NKVH; u += na) att::attn_unit(lds, Zb, YA, args.in[4] + l * HD, args.in[5] + l * HD, args.in[6] + l * NQH, u / (32 * NKVH), (u / NKVH) % 32, u % NKVH);
            }
        }
        SEAM();
        for (int rep = 0; rep <= REP_P3; ++rep) if (IN_PH) {
            { pg8::Gemm g{YA, Wab, MTOK, DM, AW}; pg8::StaticOrder S; S.init(MTOK, DM, G, bx);
              pg8::EpiGateMerge<true> E{T1, nullptr, DM, Zb + OFF_G, ZW};
              pg8::gemm_phase<pg8::EpiGateMerge<true>, pg8::StaticOrder, true, true>(lds, g, S, E); }
            { pg8::Gemm g{YG, Wglu, MTOK, SW, SW}; pg8::StaticOrder S; S.init(MTOK, SW, G, bx);
              pg8::EpiGlu E{YS, YG, SW, args.in[16] + (size_t)l * SW};
              pg8::gemm_phase<pg8::EpiGlu, pg8::StaticOrder, true, true>(lds, g, S, E); }
        }
        SEAM();
        for (int rep = 0; rep <= REP_P4; ++rep) if (IN_PH) {
            pg8::Gemm g{YS, Wsb, MTOK, DM, SW}; pg8::StaticOrder S; S.init(MTOK, DM, G, bx);
            pg8::EpiGateMerge<false> E{T1, MG, DM, Zb + OFF_G + DM, ZW};
            pg8::gemm_phase<pg8::EpiGateMerge<false>, pg8::StaticOrder, true, true>(lds, g, S, E);
        }
        SEAM();
        for (int rep = 0; rep <= REP_P5; ++rep) if (IN_PH) {
            pg8::Gemm g{MG, Wout, MTOK, DM, DM}; pg8::StaticOrder S; S.init(MTOK, DM, G, bx);
            pg8::EpiResid E{xres, X1, XB, DM, rep ? T1 : ssqB};
            pg8::gemm_phase<pg8::EpiResid, pg8::StaticOrder, true, true>(lds, g, S, E);
        }
        SEAM();
        for (int rep = 0; rep <= REP_P6; ++rep) if (IN_PH) {
            pg8::Gemm g{XB, Wfi, MTOK, 2 * DFF, DM}; pg8::StaticOrder S; S.init(MTOK, 2 * DFF, G, bx);
            pg8::EpiSwiglu E{ACT, DFF, ssqB, 1.0f / DM};
            pg8::gemm_phase<pg8::EpiSwiglu, pg8::StaticOrder, true, true>(lds, g, S, E);
        }
        SEAM();
        for (int rep = 0; rep <= REP_P7; ++rep) if (IN_PH) {
            pg8::Gemm g{ACT, Wfo, MTOK, DM, DFF}; pg8::StaticOrder S; S.init(MTOK, DM, G, bx);
            pg8::EpiResid E{X1, args.out, XB, DM, (rep && ssqN) ? T1 : ssqN};
            pg8::gemm_phase<pg8::EpiResid, pg8::StaticOrder, true, true>(lds, g, S, E);
        }
        SEAM();
    }
#undef IN_PH
#undef SEAM
}
constexpr int N_PHASES = 1 + 7 * NLAYER;

extern "C" void kernel_launch(void* const* d_in, const int* in_sizes, int n_in, void* d_out, int out_size, void* d_ws, size_t ws_size, hipStream_t stream) {
    static int grid = 0;
    if (grid == 0) {
        if (n_in != 23 || in_sizes[0] != MTOK * DM || out_size != MTOK * DM || ws_size < WS_END) { fprintf(stderr, "kernel_launch: unexpected shapes (n_in %d, ws %zu < %zu?)\n", n_in, ws_size, (size_t)WS_END); grid = -1; return; }
        int dev = 0, cus = 0, per_cu = 0;
        hipGetDevice(&dev); hipDeviceGetAttribute(&cus, hipDeviceAttributeMultiprocessorCount, dev);
        hipFuncSetAttribute((const void*)fwd_kernel, hipFuncAttributeMaxDynamicSharedMemorySize, LDS_BYTES);
        hipOccupancyMaxActiveBlocksPerMultiprocessor(&per_cu, (const void*)fwd_kernel, NTHR, LDS_BYTES);
        if (per_cu < 1) { fprintf(stderr, "kernel_launch: occupancy query says %d blocks per CU\n", per_cu); per_cu = 1; }
        (void)hipGetLastError();
        grid = cus;
    }
    if (grid < 0) return;
    hipMemsetAsync((char*)d_ws + WS_CTL, 0, CTL_ZERO_BYTES, stream);
    Args a{};
    for (int i = 0; i < 23; ++i) a.in[i] = (const float*)d_in[i];
    a.out = (float*)d_out; a.ws = (unsigned char*)d_ws;
    const int nl = MK_N_LAUNCHES;
    for (int li = 0; li < nl; ++li) {
        a.ph_lo = (nl == 1) ? 0 : li; a.ph_hi = (nl == 1) ? N_PHASES : li + 1;
        void* kargs[] = {&a};
        hipError_t e = hipLaunchCooperativeKernel((const void*)fwd_kernel, dim3(grid), dim3(NTHR), kargs, LDS_BYTES, stream);
        if (e != hipSuccess) { fprintf(stderr, "kernel_launch: cooperative launch %d failed: %s (grid %d)\n", li, hipGetErrorString(e), grid); break; }
    }
}
```
